# Optimizing an MI355X kernel written in HIP

```python
import math
import jax, jax.numpy as jnp
from jax import lax
import numpy as np

D_MODEL = 2048
BATCH = 4
SEQ = 8192
DEPTH = 4
DEC_BATCH = 8
DEC_SEQ = 64
PAST_LEN = 1024

CHUNK = 64
Q_BLOCK = 128
N_AB = (DEPTH + 1) // 2
N_C = DEPTH // 2
MLA_V = 128
MLA_HEADS = (D_MODEL // 2) // MLA_V
MLA_NOPE = 128
MLA_ROPE = 64
Q_LORA = 512
KV_LORA = 256
MLA_SCALE = (MLA_NOPE + MLA_ROPE) ** -0.5
S5_WIDTH = D_MODEL // 2
S5_GROUP = 16
S5_GROUPS = S5_WIDTH // S5_GROUP
S5_STATE = 64
DT_MIN = 1e-3
DT_MAX = 1e-1
IN_AB = Q_LORA + KV_LORA + MLA_ROPE + S5_WIDTH
MIX_AB = MLA_HEADS * MLA_V + S5_WIDTH
RET_HEADS = 8
RET_DK = D_MODEL // RET_HEADS
RET_DV = 2 * RET_DK
IN_C = 2 * RET_HEADS * RET_DK + 2 * RET_HEADS * RET_DV
D_FF = 4 * D_MODEL
ROPE_THETA = 10000.0
EPS = 1e-6
GN_EPS = 1e-5

kernel_name = 'streaming_mla_s5_retention_step'


def _normal(k, shape, scale):
    return jax.random.normal(k, shape, jnp.float32) * scale


def _rmsnorm(x, g):
    xf = x.astype(jnp.float32)
    y = xf * lax.rsqrt(jnp.mean(xf * xf, axis=-1, keepdims=True) + EPS)
    return (y * g.astype(jnp.float32)).astype(x.dtype)


def _rope(x, pos):
    half = x.shape[-1] // 2
    inv = ROPE_THETA ** (-jnp.arange(half, dtype=jnp.float32) / half)
    ang = pos.astype(jnp.float32)[:, None] * inv[None, :]
    ang = ang.reshape((ang.shape[0],) + (1,) * (x.ndim - 3) + (half,))
    cos, sin = jnp.cos(ang), jnp.sin(ang)
    xf = x.astype(jnp.float32)
    x1, x2 = xf[..., :half], xf[..., half:]
    return jnp.concatenate([x1 * cos - x2 * sin, x1 * sin + x2 * cos], axis=-1).astype(x.dtype)


def _mlp(h, w_up, w_down):
    return jnp.square(jax.nn.relu(h @ w_up)) @ w_down


def _mla_attention(q_nope, q_rope, k_nope, k_rope, v, q_pos):
    Bn, Sq = q_nope.shape[:2]
    k_chunk = jnp.arange(k_nope.shape[1]) // CHUNK

    def attend(args):
        qn, qr, qp = args
        s = (jnp.einsum('bqhd,bkhd->bhqk', qn, k_nope)
             + jnp.einsum('bqhr,bkr->bhqk', qr, k_rope)).astype(jnp.float32) * MLA_SCALE
        allowed = k_chunk[None, :] <= (qp[:, None] // CHUNK)
        s = jnp.where(allowed, s, -jnp.inf)
        p = jax.nn.softmax(s, axis=-1).astype(v.dtype)
        return jnp.einsum('bhqk,bkhd->bqhd', p, v)

    if Sq <= Q_BLOCK:
        return attend((q_nope, q_rope, q_pos))
    nb = Sq // Q_BLOCK

    def to_blocks(t):
        return jnp.moveaxis(t.reshape((Bn, nb, Q_BLOCK) + t.shape[2:]), 1, 0)

    out = lax.map(attend, (to_blocks(q_nope), to_blocks(q_rope), q_pos.reshape(nb, Q_BLOCK)))
    return jnp.moveaxis(out, 0, 1).reshape((Bn, Sq) + out.shape[3:])


def _complex_affine_combine(left, right):
    a1r, a1i, b1r, b1i = left
    a2r, a2i, b2r, b2i = right
    return (a2r * a1r - a2i * a1i,
            a2r * a1i + a2i * a1r,
            a2r * b1r - a2i * b1i + b2r,
            a2r * b1i + a2i * b1r + b2i)


def _s5_scan(u, h_re, h_im, lam_re, lam_im, log_dt, b_re, b_im, c_re, c_im, d_skip):
    f32 = jnp.float32
    Bn, S, _ = u.shape
    ug = u.reshape(Bn, S, S5_GROUPS, S5_GROUP).astype(f32)
    lr = jnp.minimum(lam_re.astype(f32), -1e-4)
    li = lam_im.astype(f32)
    dt = jnp.exp(log_dt.astype(f32))[:, None]
    mag = jnp.exp(lr * dt)
    a_re = mag * jnp.cos(li * dt)
    a_im = mag * jnp.sin(li * dt)
    den = lr * lr + li * li
    f_re = ((a_re - 1.0) * lr + a_im * li) / den
    f_im = (a_im * lr - (a_re - 1.0) * li) / den
    br = b_re.astype(f32)
    bi = b_im.astype(f32)
    bb_re = f_re[..., None] * br - f_im[..., None] * bi
    bb_im = f_re[..., None] * bi + f_im[..., None] * br
    bu_re = jnp.einsum('gnp,bsgp->bsgn', bb_re, ug)
    bu_im = jnp.einsum('gnp,bsgp->bsgn', bb_im, ug)
    hr = h_re.astype(f32)
    hi = h_im.astype(f32)
    bu_re = bu_re.at[:, 0].add(a_re * hr - a_im * hi)
    bu_im = bu_im.at[:, 0].add(a_re * hi + a_im * hr)
    A_re = jnp.broadcast_to(a_re, (1, S) + a_re.shape)
    A_im = jnp.broadcast_to(a_im, (1, S) + a_im.shape)
    _, _, s_re, s_im = lax.associative_scan(_complex_affine_combine, (A_re, A_im, bu_re, bu_im), axis=1)
    y = (jnp.einsum('gpn,bsgn->bsgp', c_re.astype(f32), s_re)
         - jnp.einsum('gpn,bsgn->bsgp', c_im.astype(f32), s_im)
         + d_skip.astype(f32) * ug)
    return y.reshape(Bn, S, S5_WIDTH).astype(u.dtype), s_re[:, -1], s_im[:, -1]


def _mixer_ab(h, pos, past_ckv, past_krope, s5_re, s5_im, w_in, q_a_norm, kv_a_norm, w_q_b, w_kv_b,
              lam_re, lam_im, log_dt, b_re, b_im, c_re, c_im, d_skip, w_glu, b_glu, w_out):
    Bn, S, _ = h.shape
    c_q, c_kv, k_rope, u = jnp.split(h @ w_in, [Q_LORA, Q_LORA + KV_LORA, Q_LORA + KV_LORA + MLA_ROPE], axis=-1)
    q = (_rmsnorm(c_q, q_a_norm) @ w_q_b).reshape(Bn, S, MLA_HEADS, MLA_NOPE + MLA_ROPE)
    q_nope = q[..., :MLA_NOPE]
    q_rope = _rope(q[..., MLA_NOPE:], pos)
    c_kv = _rmsnorm(c_kv, kv_a_norm)
    k_rope = _rope(k_rope, pos)
    all_ckv = jnp.concatenate([past_ckv.astype(c_kv.dtype), c_kv], axis=1)
    all_krope = jnp.concatenate([past_krope.astype(k_rope.dtype), k_rope], axis=1)
    kv = (all_ckv @ w_kv_b).reshape(Bn, all_ckv.shape[1], MLA_HEADS, MLA_NOPE + MLA_V)
    attn = _mla_attention(q_nope, q_rope, kv[..., :MLA_NOPE], all_krope, kv[..., MLA_NOPE:], pos)
    y, s_re, s_im = _s5_scan(u, s5_re, s5_im, lam_re, lam_im, log_dt, b_re, b_im, c_re, c_im, d_skip)
    z = jax.nn.gelu(y)
    ssm = z * jax.nn.sigmoid(z @ w_glu + b_glu)
    out = jnp.concatenate([attn.reshape(Bn, S, MLA_HEADS * MLA_V), ssm], axis=-1) @ w_out
    return out, c_kv, k_rope, s_re, s_im


def _retention_chunk(q, k, v, state, log_g):
    L = q.shape[2]
    dt = q.dtype
    idx = jnp.arange(L, dtype=jnp.float32)
    diff = idx[:, None] - idx[None, :]
    decay = jnp.where(diff >= 0, jnp.exp(log_g[:, None, None] * jnp.maximum(diff, 0.0)), 0.0).astype(dt)
    inner = jnp.einsum('bhnm,bhmv->bhnv', jnp.einsum('bhnd,bhmd->bhnm', q, k) * decay, v)
    q_dec = jnp.exp(log_g[:, None] * (idx + 1.0)).astype(dt)[None, :, :, None]
    cross = jnp.einsum('bhnd,bhdv->bhnv', q * q_dec, state)
    k_dec = jnp.exp(log_g[:, None] * (L - 1.0 - idx)).astype(dt)[None, :, :, None]
    new_state = (jnp.exp(log_g * L).astype(dt)[None, :, None, None] * state
                 + jnp.einsum('bhmd,bhmv->bhdv', k * k_dec, v))
    return inner + cross, new_state


def _mixer_c(h, pos, state, w_in, gn_gain, w_out):
    Bn, S, _ = h.shape
    qk = RET_HEADS * RET_DK
    q, k, v, g = jnp.split(h @ w_in, [qk, 2 * qk, 2 * qk + RET_HEADS * RET_DV], axis=-1)
    q = _rope(q.reshape(Bn, S, RET_HEADS, RET_DK), pos)
    k = _rope(k.reshape(Bn, S, RET_HEADS, RET_DK), pos) * RET_DK ** -0.5
    v = v.reshape(Bn, S, RET_HEADS, RET_DV)
    q, k, v = (jnp.swapaxes(t, 1, 2) for t in (q, k, v))
    log_g = jnp.log(1.0 - 2.0 ** (-5.0 - jnp.arange(RET_HEADS, dtype=jnp.float32)))
    state = state.astype(q.dtype)
    if S <= CHUNK:
        o, new_state = _retention_chunk(q, k, v, state, log_g)
    else:
        nc = S // CHUNK

        def to_chunks(t):
            return jnp.moveaxis(t.reshape(Bn, RET_HEADS, nc, CHUNK, t.shape[-1]), 2, 0)

        def step(st, qkv):
            o_c, st = _retention_chunk(qkv[0], qkv[1], qkv[2], st, log_g)
            return st, o_c

        new_state, o = lax.scan(step, state, (to_chunks(q), to_chunks(k), to_chunks(v)))
        o = jnp.moveaxis(o, 0, 2).reshape(Bn, RET_HEADS, S, RET_DV)
    of = jnp.swapaxes(o, 1, 2).astype(jnp.float32)
    mu = jnp.mean(of, axis=-1, keepdims=True)
    var = jnp.mean(jnp.square(of - mu), axis=-1, keepdims=True)
    on = (of - mu) * lax.rsqrt(var + GN_EPS) * gn_gain.astype(jnp.float32).reshape(RET_HEADS, RET_DV)
    out = (on.astype(h.dtype).reshape(Bn, S, RET_HEADS * RET_DV) * jax.nn.silu(g)) @ w_out
    return out, new_state


def _trunk(x, pos, past_ckv, past_krope, s5_re, s5_im, ret_state,
           norm_mix, norm_mlp, norm_final, w_in_ab, q_a_norm, kv_a_norm, w_q_b, w_kv_b,
           s5_lam_re, s5_lam_im, s5_log_dt, s5_b_re, s5_b_im, s5_c_re, s5_c_im, s5_d, w_glu, b_glu,
           w_out_ab, w_in_c, ret_gn, w_out_c, w_up, w_down):
    ckv_rows, krope_rows, s5_re_new, s5_im_new, ret_new = [], [], [], [], []
    for layer in range(DEPTH):
        i = layer // 2
        h = _rmsnorm(x, norm_mix[layer])
        if layer % 2 == 0:
            mix, ckv, kr, sr, si = _mixer_ab(h, pos, past_ckv[i], past_krope[i], s5_re[i], s5_im[i],
                                             w_in_ab[i], q_a_norm[i], kv_a_norm[i], w_q_b[i], w_kv_b[i],
                                             s5_lam_re[i], s5_lam_im[i], s5_log_dt[i], s5_b_re[i], s5_b_im[i],
                                             s5_c_re[i], s5_c_im[i], s5_d[i], w_glu[i], b_glu[i], w_out_ab[i])
            ckv_rows.append(ckv)
            krope_rows.append(kr)
            s5_re_new.append(sr)
            s5_im_new.append(si)
        else:
            mix, rs = _mixer_c(h, pos, ret_state[i], w_in_c[i], ret_gn[i], w_out_c[i])
            ret_new.append(rs)
        x = x + mix
        x = x + _mlp(_rmsnorm(x, norm_mlp[layer]), w_up[layer], w_down[layer])
    return (_rmsnorm(x, norm_final), jnp.stack(ckv_rows), jnp.stack(krope_rows),
            jnp.stack(s5_re_new), jnp.stack(s5_im_new), jnp.stack(ret_new))


def setup_inputs(seed: int = 0) -> dict:
    key = jax.random.key(seed)
    k = jax.random.split(key, 31)
    f32 = jnp.float32
    G, N, P = S5_GROUPS, S5_STATE, S5_GROUP
    return {
        'x_prompt': _normal(k[0], (BATCH, SEQ, D_MODEL), 1.0),
        'x_sample': _normal(k[1], (DEC_BATCH, DEC_SEQ, D_MODEL), 1.0),
        'cache_mla_ckv': _normal(k[2], (N_AB, DEC_BATCH, PAST_LEN, KV_LORA), 1.0),
        'cache_mla_krope': _normal(k[3], (N_AB, DEC_BATCH, PAST_LEN, MLA_ROPE), 1.0),
        'state_s5_re': _normal(k[4], (N_AB, DEC_BATCH, G, N), 0.1),
        'state_s5_im': _normal(k[5], (N_AB, DEC_BATCH, G, N), 0.1),
        'state_ret': _normal(k[6], (N_C, DEC_BATCH, RET_HEADS, RET_DK, RET_DV), 1.0),
        'norm_mix': 1.0 + _normal(k[7], (DEPTH, D_MODEL), 0.02),
        'norm_mlp': 1.0 + _normal(k[8], (DEPTH, D_MODEL), 0.02),
        'norm_final': 1.0 + _normal(k[9], (D_MODEL,), 0.02),
        'w_in_ab': _normal(k[10], (N_AB, D_MODEL, IN_AB), D_MODEL ** -0.5),
        'q_a_norm': 1.0 + _normal(k[11], (N_AB, Q_LORA), 0.02),
        'kv_a_norm': 1.0 + _normal(k[12], (N_AB, KV_LORA), 0.02),
        'w_q_b': _normal(k[13], (N_AB, Q_LORA, MLA_HEADS * (MLA_NOPE + MLA_ROPE)), Q_LORA ** -0.5),
        'w_kv_b': _normal(k[14], (N_AB, KV_LORA, MLA_HEADS * (MLA_NOPE + MLA_V)), KV_LORA ** -0.5),
        's5_lam_re': -0.5 + _normal(k[15], (N_AB, G, N), 0.01),
        's5_lam_im': math.pi * jnp.arange(N, dtype=f32) + _normal(k[16], (N_AB, G, N), 0.01),
        's5_log_dt': jax.random.uniform(k[17], (N_AB, G), f32, math.log(DT_MIN), math.log(DT_MAX)),
        's5_b_re': _normal(k[18], (N_AB, G, N, P), (2 * P) ** -0.5),
        's5_b_im': _normal(k[19], (N_AB, G, N, P), (2 * P) ** -0.5),
        's5_c_re': _normal(k[20], (N_AB, G, P, N), N ** -0.5),
        's5_c_im': _normal(k[21], (N_AB, G, P, N), N ** -0.5),
        's5_d': _normal(k[22], (N_AB, G, P), 1.0),
        'w_glu': _normal(k[23], (N_AB, S5_WIDTH, S5_WIDTH), S5_WIDTH ** -0.5),
        'b_glu': _normal(k[24], (N_AB, S5_WIDTH), 0.01),
        'w_out_ab': _normal(k[25], (N_AB, MIX_AB, D_MODEL), MIX_AB ** -0.5),
        'w_in_c': _normal(k[26], (N_C, D_MODEL, IN_C), D_MODEL ** -0.5),
        'ret_gn': 1.0 + _normal(k[27], (N_C, RET_HEADS * RET_DV), 0.02),
        'w_out_c': _normal(k[28], (N_C, RET_HEADS * RET_DV, D_MODEL), (RET_HEADS * RET_DV) ** -0.5),
        'w_up': _normal(k[29], (DEPTH, D_MODEL, D_FF), D_MODEL ** -0.5),
        'w_down': _normal(k[30], (DEPTH, D_FF, D_MODEL), D_FF ** -0.5),
    }


def reference(x_prompt, x_sample, cache_mla_ckv, cache_mla_krope, state_s5_re, state_s5_im, state_ret,
              norm_mix, norm_mlp, norm_final, w_in_ab, q_a_norm, kv_a_norm, w_q_b, w_kv_b,
              s5_lam_re, s5_lam_im, s5_log_dt, s5_b_re, s5_b_im, s5_c_re, s5_c_im, s5_d, w_glu, b_glu,
              w_out_ab, w_in_c, ret_gn, w_out_c, w_up, w_down):
    weights = (norm_mix, norm_mlp, norm_final, w_in_ab, q_a_norm, kv_a_norm, w_q_b, w_kv_b,
               s5_lam_re, s5_lam_im, s5_log_dt, s5_b_re, s5_b_im, s5_c_re, s5_c_im, s5_d, w_glu, b_glu,
               w_out_ab, w_in_c, ret_gn, w_out_c, w_up, w_down)
    bp, sp, _ = x_prompt.shape
    dt = x_prompt.dtype
    empty_ckv = jnp.zeros((N_AB, bp, 0, KV_LORA), dt)
    empty_krope = jnp.zeros((N_AB, bp, 0, MLA_ROPE), dt)
    zero_s5 = jnp.zeros((N_AB, bp, S5_GROUPS, S5_STATE), jnp.float32)
    zero_ret = jnp.zeros((N_C, bp, RET_HEADS, RET_DK, RET_DV), dt)
    pos_p = jnp.arange(sp)
    y_prompt, ckv_p, krope_p, s5_re_p, s5_im_p, ret_p = _trunk(
        x_prompt, pos_p, empty_ckv, empty_krope, zero_s5, zero_s5, zero_ret, *weights)
    past = cache_mla_ckv.shape[2]
    pos_s = past + jnp.arange(x_sample.shape[1])
    y_sample, ckv_s, krope_s, s5_re_s, s5_im_s, ret_s = _trunk(
        x_sample, pos_s, cache_mla_ckv, cache_mla_krope, state_s5_re, state_s5_im, state_ret, *weights)
    return (y_prompt, y_sample, ckv_p, krope_p, s5_re_p, s5_im_p, ret_p,
            ckv_s, krope_s, s5_re_s, s5_im_s, ret_s)
```

```cpp
#include <hip/hip_runtime.h>
#include <cstdio>
#include <cstdint>

#define LAS __attribute__((address_space(3)))
#define GAS __attribute__((address_space(1)))
typedef unsigned short bf16_t;
typedef short bf16x8 __attribute__((ext_vector_type(8)));
typedef short s16x4 __attribute__((ext_vector_type(4)));
typedef float f32x4 __attribute__((ext_vector_type(4)));
typedef float f32x2 __attribute__((ext_vector_type(2)));
typedef float f32x16 __attribute__((ext_vector_type(16)));
typedef unsigned u32x4 __attribute__((ext_vector_type(4)));
typedef unsigned u32x2 __attribute__((ext_vector_type(2)));

typedef __bf16 bf16x2_t __attribute__((ext_vector_type(2)));
__device__ __forceinline__ unsigned cvt_pk_bf16(float lo, float hi) { const f32x2 v = {lo, hi}; const bf16x2_t b = __builtin_convertvector(v, bf16x2_t); return __builtin_bit_cast(unsigned, b); }
__device__ __forceinline__ float bf_lo(unsigned w) { return __uint_as_float(w << 16); }
__device__ __forceinline__ float bf_hi(unsigned w) { return __uint_as_float(w & 0xffff0000u); }
__device__ __forceinline__ float bf2f(bf16_t b) { return __uint_as_float(((unsigned)b) << 16); }
__device__ __forceinline__ bf16_t f2bf(float f) { return (bf16_t)(cvt_pk_bf16(f, 0.f) & 0xffffu); }

namespace pg8 {
constexpr int BM = 256, BK = 64, HALF = 128, HTB = HALF * BK * 2  , STAGE_BYTES = 8 * HTB, NXCD = 8, WGM = 4;
__host__ __device__ __forceinline__ int lds_byte(int r, int c) { const int st = (r >> 4) * 2 + (c >> 5), rr = r & 15, cc = c & 31, ob = rr * 64 + cc * 2; return st * 1024 + (ob ^ (((ob >> 9) & 1) << 5)); }
__host__ __device__ __forceinline__ void stage_rc(int b, int& R, int& C) { const int st = b / 1024, sb = b % 1024, swz = sb ^ (((sb >> 9) & 1) << 5); R = (st >> 1) * 16 + swz / 64; C = (st & 1) * 32 + (swz % 64) / 2; }
__host__ __device__ __forceinline__ int perm32(int rho) { const int n = rho >> 4, i = rho & 15; return 8 * (i >> 2) + 4 * n + (i & 3); }

struct Unit { int pm, pn, pk; };
struct Gemm { const bf16_t* A; const bf16_t* Bt; int M, N, K, lda, ldb, kslice; };

struct StaticOrder {
    int nM, nN, nwg, G, c, wgm;
    __host__ __device__ void init(int M, int N, int G_, int c_, int wgm_ = WGM) { nM = M / BM; nN = N / BM; nwg = nM * nN; G = G_; c = c_; wgm = wgm_; }
    int skip = 0, vc = 0;
    __host__ __device__ bool next(int i, Unit& u) const {
        long L = (long)i * G + c;
        if (skip > 0 && i > 0) { if (vc < skip) return false; L = (long)G + (long)(i - 1) * (G - skip) + (vc - skip); }
        if (L >= nwg) return false;
        int wgid = (int)L; { const int q = nwg / NXCD, r = nwg % NXCD, xcd = wgid % NXCD, off = wgid / NXCD; wgid = (xcd < r ? xcd * (q + 1) : r * (q + 1) + (xcd - r) * q) + off; }
        const int nig = wgm * nN, gid = wgid / nig, fm = gid * wgm, gsz = (nM - fm) < wgm ? (nM - fm) : wgm;
        u.pm = fm + ((wgid % nig) % gsz); u.pn = (wgid % nig) / gsz; u.pk = 0; return true;
    }
    __device__ __forceinline__ void a_ready(const Unit&) const {}
    __device__ __forceinline__ void done(const Unit&) const {}
};


struct SplitOrder {
    int nM, nN, S, G, c;
    __host__ __device__ void init(int M, int N, int S_, int G_, int c_) { nM = M / BM; nN = N / BM; S = S_; G = G_; c = c_; }
    __host__ __device__ bool next(int i, Unit& u) const { const int L = i * G + c; if (L >= nM * nN * S) return false; u.pn = L % nN; u.pm = (L / nN) % nM; u.pk = L / (nN * nM); return true; }
    __device__ __forceinline__ void a_ready(const Unit&) const {}
    __device__ __forceinline__ void done(const Unit&) const {}
};
struct EpiSlab {
    static constexpr bool PERM = true, AFTER_DRAIN = false;
    float* P; int ldc; int rows;
    __device__ __forceinline__ void operator()(const f32x4 (&acc)[2][2][4][2], const Unit& u, int wr, int wc, int fr, int fq) const {
        const int row0 = u.pm * BM + wr * 64 + fr, col0 = u.pn * BM + wc * 32 + 8 * fq;
#pragma unroll
        for (int ai = 0; ai < 2; ++ai)
#pragma unroll
            for (int m = 0; m < 4; ++m) { float* p = P + ((size_t)u.pk * rows + row0 + ai * HALF + m * 16) * ldc + col0;
#pragma unroll
                for (int bj = 0; bj < 2; ++bj) { *(f32x4*)(p + bj * HALF) = acc[ai][bj][m][0]; *(f32x4*)(p + bj * HALF + 4) = acc[ai][bj][m][1]; } }
    }
};

template <int ACT> struct EpiBf16 {
    static constexpr bool PERM = true, AFTER_DRAIN = false;
    const f32x2* rope; int rmode;
    bool nt;
    bf16_t* O; int ldc; const float* RSS;
    __device__ __forceinline__ void rope_load(f32x2 (&cs)[2][2][4], int bt, const int (&tj)[2], int row0) const {
        const int ai = bt >> 1, mp = bt & 1, st = (rmode == 1) ? 1 : 4;
#pragma unroll
        for (int mm = 0; mm < 2; ++mm) { const int mrow = row0 + ai * HALF + (2 * mp + mm) * 16; const int pos = mrow < 32768 ? (mrow & 8191) : 1024 + ((mrow - 32768) & 63);
#pragma unroll
            for (int bj = 0; bj < 2; ++bj) { const f32x2* p = rope + (size_t)pos * 128 + (tj[bj] >= 0 ? tj[bj] : 0);
                if (rmode == 1) { const f32x4 c01 = *(const f32x4*)p, c23 = *(const f32x4*)(p + 2); cs[mm][bj][0] = (f32x2){c01.x, c01.y}; cs[mm][bj][1] = (f32x2){c01.z, c01.w}; cs[mm][bj][2] = (f32x2){c23.x, c23.y}; cs[mm][bj][3] = (f32x2){c23.z, c23.w}; }
                else { cs[mm][bj][0] = p[0]; cs[mm][bj][1] = p[st]; cs[mm][bj][2] = p[2 * st]; cs[mm][bj][3] = p[3 * st]; } } }
    }
    template <bool ROPE>
    __device__ __forceinline__ void body(const f32x4 (&acc)[2][2][4][2], const float (&rsv)[2][4], const int (&tj)[2], const float (&sc)[2], int row0, int col0) const {
        f32x2 csn[2][2][4];
        if constexpr (ROPE) rope_load(csn, 0, tj, row0);
#pragma unroll
        for (int bt = 0; bt < 4; ++bt) { const int ai = bt >> 1, mp = bt & 1;
                f32x2 cs[2][2][4];
                if constexpr (ROPE) {
#pragma unroll
                    for (int mm = 0; mm < 2; ++mm)
#pragma unroll
                        for (int bj = 0; bj < 2; ++bj)
#pragma unroll
                            for (int q = 0; q < 4; ++q) cs[mm][bj][q] = csn[mm][bj][q];
                    if (bt < 3) rope_load(csn, bt + 1, tj, row0); }
#pragma unroll
                for (int mm = 0; mm < 2; ++mm) { const int m = 2 * mp + mm; bf16_t* rowp = O + (size_t)(row0 + ai * HALF + m * 16) * ldc + col0;
                    const float rs = RSS ? 1.0f / sqrtf(rsv[ai][m] * (1.0f / 2048.0f) + 1e-6f) : 1.0f;
#pragma unroll
                    for (int bj = 0; bj < 2; ++bj) { f32x4 v0 = acc[ai][bj][m][0] * rs, v1 = acc[ai][bj][m][1] * rs;
                        if constexpr (ROPE) {
                            const f32x2 c0 = cs[mm][bj][0], c1 = cs[mm][bj][1], c2 = cs[mm][bj][2], c3 = cs[mm][bj][3]; const float s_ = sc[bj]; const bool on = tj[bj] >= 0;
                            const f32x4 a = v0, b = v1;
                            v0[0] = on ? (a[0] * c0.x - a[1] * c0.y) * s_ : a[0]; v0[1] = on ? (a[0] * c0.y + a[1] * c0.x) * s_ : a[1]; v0[2] = on ? (a[2] * c1.x - a[3] * c1.y) * s_ : a[2]; v0[3] = on ? (a[2] * c1.y + a[3] * c1.x) * s_ : a[3];
                            v1[0] = on ? (b[0] * c2.x - b[1] * c2.y) * s_ : b[0]; v1[1] = on ? (b[0] * c2.y + b[1] * c2.x) * s_ : b[1]; v1[2] = on ? (b[2] * c3.x - b[3] * c3.y) * s_ : b[2]; v1[3] = on ? (b[2] * c3.y + b[3] * c3.x) * s_ : b[3];
                        }
                        if (ACT == 1) {
#pragma unroll
                            for (int j = 0; j < 4; ++j) { const float a = fmaxf(v0[j], 0.f), b = fmaxf(v1[j], 0.f); v0[j] = a * a; v1[j] = b * b; } }
                        u32x4 w; w.x = cvt_pk_bf16(v0[0], v0[1]); w.y = cvt_pk_bf16(v0[2], v0[3]); w.z = cvt_pk_bf16(v1[0], v1[1]); w.w = cvt_pk_bf16(v1[2], v1[3]);
                        if (nt) __builtin_nontemporal_store(w, (u32x4*)(rowp + bj * HALF)); else *(u32x4*)(rowp + bj * HALF) = w; } } }
    }
    __device__ __forceinline__ void operator()(const f32x4 (&acc)[2][2][4][2], const Unit& u, int wr, int wc, int fr_, int fq_) const {
        int t2 = threadIdx.x; asm volatile("" : "+v"(t2)); const int fr = t2 & 15, fq = (t2 & 63) >> 4; (void)fr_; (void)fq_;
        const int row0 = u.pm * BM + wr * 64 + fr, col0 = u.pn * BM + wc * 32 + 8 * fq;
        float rsv[2][4];
        { const float* rp = RSS ? RSS + row0 : (const float*)O;
#pragma unroll
        for (int ai = 0; ai < 2; ++ai)
#pragma unroll
            for (int m = 0; m < 4; ++m) rsv[ai][m] = rp[ai * HALF + m * 16]; }
        int tj[2]; float sc[2];
#pragma unroll
        for (int bj = 0; bj < 2; ++bj) { const int col = col0 + bj * HALF; tj[bj] = -1; sc[bj] = 1.0f;
            if (rmode == 1) { if (col < 4096) { tj[bj] = (col & 255) >> 1; sc[bj] = (col >= 2048) ? 0.0625f : 1.0f; } }
            else if (rmode == 2) { const int r = col % 192; if (r >= 128) tj[bj] = 2 * (r - 128); } }
        const bool anyrope = (rmode != 0) && __any((tj[0] >= 0) | (tj[1] >= 0));
        if (anyrope) body<true>(acc, rsv, tj, sc, row0, col0); else body<false>(acc, rsv, tj, sc, row0, col0);
    }
};
struct EpiGlu {
    static constexpr bool PERM = true, AFTER_DRAIN = false;
    bf16_t* O; int ldc; int ocol0; const bf16_t* Z; int ldz; const float* bias;
    __device__ __forceinline__ void operator()(const f32x4 (&acc)[2][2][4][2], const Unit& u, int wr, int wc, int fr, int fq) const {
        const int row0 = u.pm * BM + wr * 64 + fr, col0 = u.pn * BM + wc * 32 + 8 * fq;
        f32x4 bv[2][2];
#pragma unroll
        for (int bj = 0; bj < 2; ++bj)
#pragma unroll
            for (int n = 0; n < 2; ++n) bv[bj][n] = *(const f32x4*)(bias + col0 + bj * HALF + 4 * n);
#pragma unroll
        for (int ai = 0; ai < 2; ++ai) {
            u32x4 zq[4][2];
#pragma unroll
            for (int m = 0; m < 4; ++m)
#pragma unroll
                for (int bj = 0; bj < 2; ++bj) zq[m][bj] = *(const u32x4*)(Z + (size_t)(row0 + ai * HALF + m * 16) * ldz + col0 + bj * HALF);
#pragma unroll
            for (int m = 0; m < 4; ++m) { const size_t r = (size_t)(row0 + ai * HALF + m * 16);
#pragma unroll
                for (int bj = 0; bj < 2; ++bj) { const f32x4 v0 = acc[ai][bj][m][0] + bv[bj][0], v1 = acc[ai][bj][m][1] + bv[bj][1];
                    const u32x4 zz = zq[m][bj];
                    float o[8], zf[8] = {bf_lo(zz.x), bf_hi(zz.x), bf_lo(zz.y), bf_hi(zz.y), bf_lo(zz.z), bf_hi(zz.z), bf_lo(zz.w), bf_hi(zz.w)};
#pragma unroll
                    for (int j = 0; j < 4; ++j) { o[j] = zf[j] / (1.f + __expf(-v0[j])); o[4 + j] = zf[4 + j] / (1.f + __expf(-v1[j])); }
                    u32x4 w; w.x = cvt_pk_bf16(o[0], o[1]); w.y = cvt_pk_bf16(o[2], o[3]); w.z = cvt_pk_bf16(o[4], o[5]); w.w = cvt_pk_bf16(o[6], o[7]);
                    *(u32x4*)(O + r * ldc + ocol0 + col0 + bj * HALF) = w; } } }
    }
};
struct EpiRes {
    static constexpr bool PERM = true, AFTER_DRAIN = false;
    const float* baseP; const bf16_t* baseB; int ldc;
    bf16_t* XB; float* RSS;
    __device__ __forceinline__ void row_out(const f32x4& x, const f32x4& y, bf16_t* p, float& ss) const {
        *(u32x4*)p = (u32x4){cvt_pk_bf16(x[0], x[1]), cvt_pk_bf16(x[2], x[3]), cvt_pk_bf16(y[0], y[1]), cvt_pk_bf16(y[2], y[3])};
        ss += ((x[0] * x[0] + x[1] * x[1]) + (x[2] * x[2] + x[3] * x[3])) + ((y[0] * y[0] + y[1] * y[1]) + (y[2] * y[2] + y[3] * y[3])); }
    __device__ __forceinline__ void row_ss(float ss, int row, int slot, int fq) const {
        ss += __builtin_bit_cast(float, __builtin_amdgcn_ds_swizzle(__builtin_bit_cast(int, ss), 0x401F));
        { const auto rr = __builtin_amdgcn_permlane32_swap(__float_as_uint(ss), __float_as_uint(ss), false, false); ss = __uint_as_float(rr[0]) + __uint_as_float(rr[1]); }
        if (fq == 0) RSS[(size_t)row * 32 + slot] = ss; }
    __device__ __forceinline__ void operator()(const f32x4 (&acc)[2][2][4][2], const Unit& u, int wr, int wc, int fr, int fq) const {
        const int row0 = u.pm * BM + wr * 64 + fr, col0 = u.pn * BM + wc * 32 + 8 * fq;
        if (baseB) { u32x4 w[2][4][2];
#pragma unroll
            for (int ai = 0; ai < 2; ++ai)
#pragma unroll
                for (int m = 0; m < 4; ++m)
#pragma unroll
                    for (int bj = 0; bj < 2; ++bj) w[ai][m][bj] = *(const u32x4*)(baseB + (size_t)(row0 + ai * HALF + m * 16) * ldc + col0 + bj * HALF);
#pragma unroll
            for (int ai = 0; ai < 2; ++ai)
#pragma unroll
                for (int m = 0; m < 4; ++m) { const int row = row0 + ai * HALF + m * 16; float ss = 0.f;
#pragma unroll
                    for (int bj = 0; bj < 2; ++bj) { const u32x4 q = w[ai][m][bj];
                        const f32x4 x = (f32x4){bf_lo(q.x), bf_hi(q.x), bf_lo(q.y), bf_hi(q.y)} + acc[ai][bj][m][0], y = (f32x4){bf_lo(q.z), bf_hi(q.z), bf_lo(q.w), bf_hi(q.w)} + acc[ai][bj][m][1];
                        row_out(x, y, XB + (size_t)row * ldc + col0 + bj * HALF, ss); }
                    row_ss(ss, row, u.pn * 4 + wc, fq); } }
        else {
#pragma unroll
            for (int ai = 0; ai < 2; ++ai)
#pragma unroll
                for (int mp = 0; mp < 2; ++mp) { f32x4 bf[2][2][2];
#pragma unroll
                    for (int mm = 0; mm < 2; ++mm)
#pragma unroll
                        for (int bj = 0; bj < 2; ++bj) { const float* p = baseP + (size_t)(row0 + ai * HALF + (2 * mp + mm) * 16) * ldc + col0 + bj * HALF; bf[mm][bj][0] = *(const f32x4*)p; bf[mm][bj][1] = *(const f32x4*)(p + 4); }
#pragma unroll
                    for (int mm = 0; mm < 2; ++mm) { const int m = 2 * mp + mm; const int row = row0 + ai * HALF + m * 16; float ss = 0.f;
#pragma unroll
                        for (int bj = 0; bj < 2; ++bj) { const f32x4 x = bf[mm][bj][0] + acc[ai][bj][m][0], y = bf[mm][bj][1] + acc[ai][bj][m][1];
                            row_out(x, y, XB + (size_t)row * ldc + col0 + bj * HALF, ss); }
                        row_ss(ss, row, u.pn * 4 + wc, fq); } } }
    }
};

__device__ __forceinline__ void pg8_glds16s(const void* sbase, unsigned voff, unsigned m0v) { unsigned keep;
    const unsigned lo = __builtin_amdgcn_readfirstlane((unsigned)(size_t)sbase), hi = __builtin_amdgcn_readfirstlane((unsigned)((size_t)sbase >> 32));
    const unsigned long long sb = ((unsigned long long)hi << 32) | lo;
    asm volatile("s_mov_b32 %0, m0\n\ts_mov_b32 m0, %3\n\ts_nop 0\n\tglobal_load_lds_dwordx4 %1, %2\n\ts_mov_b32 m0, %0" : "=&s"(keep) : "v"(voff), "s"(sb), "s"(m0v) : "memory"); }
template <class Epi, class Sched, bool ALIGN_EPI = false, bool SP2 = false>
__device__ __forceinline__ void gemm_phase(LAS unsigned char* lds, const Gemm g, const Sched& S_in, const Epi& E) {
    Sched S = S_in; asm volatile("" : "+s"(S.c));
    int tid_ = threadIdx.x; asm volatile("" : "+v"(tid_));
    const int tid = tid_, wid = __builtin_amdgcn_readfirstlane(tid >> 6), lane = tid & 63, wr = wid >> 2, wc = wid & 3, fr = lane & 15, fq = lane >> 4;
    const int K = g.K, nt = K / BK;
    unsigned voffA[2], voffB[2];
#pragma unroll
    for (int i = 0; i < 2; ++i) { int R, C; stage_rc(tid * 16 + i * 8192, R, C); const int Rb = Epi::PERM ? ((R & ~31) + perm32(R & 31)) : R;
        voffA[i] = (unsigned)(R * g.lda + C) * 2u; voffB[i] = (unsigned)(Rb * BK + C) * 2u; }
    const size_t kstep = (size_t)(BK * 2), kstepB = (size_t)(BM * BK * 2);
    const size_t hstepA = (size_t)HALF * g.lda * 2, hstepB = (size_t)HALF * BK * 2;
    const size_t tstepA = 2 * hstepA, tstepB = (size_t)(g.ldb / BK) * (BM * BK * 2);
    const unsigned ldsbase_ = (unsigned)(size_t)lds;
    const unsigned ldsw = (unsigned)wid * 1024u;
    const int aoff = lds_byte(wr * 64 + fr, fq * 8), boff = lds_byte(wc * 32 + fr, fq * 8);
#define PG8_SA(b, h) (((b) * 2 + (h)) * HTB)
#define PG8_SB(b, h) ((4 + (b) * 2 + (h)) * HTB)
#define PG8_STAGE(bufoff, gbase, voff) do { _Pragma("unroll") for (int _i = 0; _i < 2; ++_i) \
        pg8_glds16s((gbase), (voff)[_i], (unsigned)__builtin_amdgcn_readfirstlane((int)(ldsbase_ + (bufoff) + ldsw + _i * 8192))); } while (0)
#define PG8_LDA(dst, b, h) do { _Pragma("unroll") for (int m = 0; m < 4; ++m) _Pragma("unroll") for (int k = 0; k < 2; ++k) dst[m][k] = *(const LAS bf16x8*)(lds + PG8_SA(b, h) + aoff + m * 2048 + k * 1024); } while (0)
#define PG8_LDB(dst, b, h) do { _Pragma("unroll") for (int n = 0; n < 2; ++n) _Pragma("unroll") for (int k = 0; k < 2; ++k) dst[n][k] = *(const LAS bf16x8*)(lds + PG8_SB(b, h) + boff + n * 2048 + k * 1024); } while (0)
#define PG8_MMA(ai, bj, At, Bt) do { __builtin_amdgcn_s_setprio(1); _Pragma("unroll") for (int m = 0; m < 4; ++m) _Pragma("unroll") for (int n = 0; n < 2; ++n) _Pragma("unroll") for (int k = 0; k < 2; ++k) \
        acc[ai][bj][m][n] = __builtin_amdgcn_mfma_f32_16x16x32_bf16(Bt[n][k], At[m][k], acc[ai][bj][m][n], 0, 0, 0); __builtin_amdgcn_s_setprio(0); } while (0)
#define PG8_WAIT_V(n) asm volatile("s_waitcnt vmcnt(" #n ")" ::: "memory")
#define PG8_WAIT_L(n) asm volatile("s_waitcnt lgkmcnt(" #n ")" ::: "memory")
#define PG8_BAR __builtin_amdgcn_s_barrier()
#define PG8_SCHED __builtin_amdgcn_sched_barrier(0)
    Unit cur, nxt; int ui = 0;
    if (!S.next(0, cur)) return;
    f32x4 acc[2][2][4][2];
#pragma unroll
    for (int a = 0; a < 2; ++a)
#pragma unroll
        for (int b = 0; b < 2; ++b)
#pragma unroll
            for (int m = 0; m < 4; ++m)
#pragma unroll
                for (int n = 0; n < 2; ++n) acc[a][b][m][n] = (f32x4){0.f, 0.f, 0.f, 0.f};
    bf16x8 At[4][2], B0[2][2], B1[2][2];
    const size_t ksb = (size_t)g.kslice * 2, ksbB = (size_t)(g.kslice / BK) * (BM * BK * 2);
    const char* cA = (const char*)g.A + (size_t)cur.pm * tstepA + cur.pk * ksb; const char* cB = (const char*)g.Bt + (size_t)cur.pn * tstepB + cur.pk * ksbB;
    S.a_ready(cur);
    if constexpr (SP2) {
        PG8_STAGE(PG8_SB(0, 0), cB, voffB); PG8_STAGE(PG8_SB(0, 1), cB + hstepB, voffB); PG8_STAGE(PG8_SA(0, 0), cA, voffA); PG8_STAGE(PG8_SA(0, 1), cA + hstepA, voffA);
        if (wr == 1) PG8_BAR;
        PG8_WAIT_V(2); PG8_BAR;
        PG8_STAGE(PG8_SB(1, 0), cB + kstepB, voffB); PG8_STAGE(PG8_SA(1, 0), cA + kstep, voffA); PG8_STAGE(PG8_SB(1, 1), cB + hstepB + kstepB, voffB);
        PG8_WAIT_V(6); PG8_BAR;
    } else {
        PG8_STAGE(PG8_SB(0, 0), cB, voffB); PG8_STAGE(PG8_SA(0, 0), cA, voffA); PG8_STAGE(PG8_SB(0, 1), cB + hstepB, voffB); PG8_STAGE(PG8_SA(0, 1), cA + hstepA, voffA);
        if (wr == 1) PG8_BAR;
        PG8_WAIT_V(4); PG8_BAR;
        PG8_STAGE(PG8_SB(1, 0), cB + kstepB, voffB); PG8_STAGE(PG8_SA(1, 0), cA + kstep, voffA); PG8_STAGE(PG8_SB(1, 1), cB + hstepB + kstepB, voffB);
        PG8_WAIT_V(6); PG8_BAR;
    }
    for (;;) {
        const bool has_next = S.next(ui + 1, nxt);
        const char* nA = has_next ? (const char*)g.A + (size_t)nxt.pm * tstepA + nxt.pk * ksb : cA; const char* nB = has_next ? (const char*)g.Bt + (size_t)nxt.pn * tstepB + nxt.pk * ksbB : cB;
        for (int t = 0; t < nt; t += 2) {
            const bool last = (t == nt - 2);
            const char* a1 = cA + (size_t)(t + 1) * kstep;
            const char* a2 = last ? nA : cA + (size_t)(t + 2) * kstep; const char* b2 = last ? nB : cB + (size_t)(t + 2) * kstepB;
            const char* a3 = a2 + kstep; const char* b3 = b2 + kstepB;
            if (last && has_next) S.a_ready(nxt);
            if constexpr (SP2) {
            PG8_LDB(B0, 0, 0); PG8_LDB(B1, 0, 1); PG8_SCHED; PG8_LDA(At, 0, 0); PG8_STAGE(PG8_SA(1, 1), a1 + hstepA, voffA);
            PG8_WAIT_V(8); PG8_WAIT_L(0); PG8_BAR; PG8_MMA(0, 0, At, B0); PG8_MMA(0, 1, At, B1); PG8_BAR; PG8_SCHED;
            PG8_LDA(At, 0, 1); PG8_STAGE(PG8_SB(0, 0), b2, voffB); PG8_STAGE(PG8_SB(0, 1), b2 + hstepB, voffB); PG8_STAGE(PG8_SA(0, 0), a2, voffA);
            PG8_WAIT_V(8); PG8_WAIT_L(0); PG8_BAR; PG8_MMA(1, 0, At, B0); PG8_MMA(1, 1, At, B1); PG8_BAR; PG8_SCHED;
            PG8_LDB(B0, 1, 0); PG8_LDB(B1, 1, 1); PG8_SCHED; PG8_LDA(At, 1, 0); PG8_STAGE(PG8_SA(0, 1), a2 + hstepA, voffA);
            PG8_WAIT_V(8); PG8_WAIT_L(0); PG8_BAR; PG8_MMA(0, 0, At, B0); PG8_MMA(0, 1, At, B1); PG8_BAR; PG8_SCHED;
            PG8_LDA(At, 1, 1); PG8_STAGE(PG8_SB(1, 0), b3, voffB); PG8_STAGE(PG8_SB(1, 1), b3 + hstepB, voffB); PG8_STAGE(PG8_SA(1, 0), a3, voffA);
            PG8_WAIT_V(8); PG8_WAIT_L(0); PG8_BAR; PG8_MMA(1, 0, At, B0); PG8_MMA(1, 1, At, B1); PG8_BAR; PG8_SCHED;
            } else {
            PG8_LDB(B0, 0, 0); PG8_SCHED; PG8_LDA(At, 0, 0); PG8_STAGE(PG8_SA(1, 1), a1 + hstepA, voffA);
            PG8_WAIT_L(8); PG8_BAR; PG8_WAIT_L(0); PG8_MMA(0, 0, At, B0); PG8_BAR; PG8_SCHED;
            PG8_LDB(B1, 0, 1); PG8_STAGE(PG8_SB(0, 0), b2, voffB);
            PG8_BAR; PG8_WAIT_L(0); PG8_MMA(0, 1, At, B1); PG8_BAR;
            PG8_LDA(At, 0, 1); PG8_STAGE(PG8_SA(0, 0), a2, voffA);
            PG8_BAR; PG8_WAIT_L(0); PG8_MMA(1, 0, At, B0); PG8_BAR; PG8_SCHED;
            PG8_STAGE(PG8_SB(0, 1), b2 + hstepB, voffB);
            PG8_WAIT_V(6); PG8_BAR; PG8_MMA(1, 1, At, B1); PG8_BAR;
            PG8_LDB(B0, 1, 0); PG8_SCHED; PG8_LDA(At, 1, 0); PG8_STAGE(PG8_SA(0, 1), a2 + hstepA, voffA);
            PG8_WAIT_L(8); PG8_BAR; PG8_WAIT_L(0); PG8_MMA(0, 0, At, B0); PG8_BAR; PG8_SCHED;
            PG8_LDB(B1, 1, 1); PG8_STAGE(PG8_SB(1, 0), b3, voffB);
            PG8_BAR; PG8_WAIT_L(0); PG8_MMA(0, 1, At, B1); PG8_BAR;
            PG8_LDA(At, 1, 1); PG8_STAGE(PG8_SA(1, 0), a3, voffA);
            PG8_BAR; PG8_WAIT_L(0); PG8_MMA(1, 0, At, B0); PG8_BAR; PG8_SCHED;
            PG8_STAGE(PG8_SB(1, 1), b3 + hstepB, voffB);
            PG8_WAIT_V(6); PG8_BAR; PG8_MMA(1, 1, At, B1); PG8_BAR;
            }
        }
        if constexpr (ALIGN_EPI) { if (wr == 0) PG8_BAR; }
        if constexpr (!Epi::AFTER_DRAIN) { E(acc, cur, wr, wc, fr, fq); S.done(cur); }
        if (!has_next) break;
#pragma unroll
        for (int a = 0; a < 2; ++a)
#pragma unroll
            for (int b = 0; b < 2; ++b)
#pragma unroll
                for (int m = 0; m < 4; ++m)
#pragma unroll
                    for (int n = 0; n < 2; ++n) acc[a][b][m][n] = (f32x4){0.f, 0.f, 0.f, 0.f};
        cur = nxt; cA = nA; cB = nB; ++ui;
        if constexpr (ALIGN_EPI) { if (wr == 1) PG8_BAR; }
    }
    PG8_WAIT_V(0);
    if constexpr (!ALIGN_EPI) { if (wr == 0) PG8_BAR; }
    PG8_BAR;
    if constexpr (Epi::AFTER_DRAIN) { E.fused(acc, cur, wr, wc, fr, fq, lds, wid, lane); S.done(cur); }
#undef PG8_SA
#undef PG8_SB
#undef PG8_STAGE
#undef PG8_LDA
#undef PG8_LDB
#undef PG8_MMA
#undef PG8_WAIT_V
#undef PG8_WAIT_L
#undef PG8_BAR
#undef PG8_SCHED
}
}
#define XB_TMO      128
#define XB_XCNT(j)  (256  + 64 * (j))
#define XB_XSUB(j)  (1280 + 64 * (j))
#define XB_XGEN(j)  (2304 + 64 * (j))
#define XB_TOP      3328
#define XB_TOPGEN   3392
#define XCD_BAR_WORDS 3456
#define XB_SPIN_CAP (1u << 18)

__device__ __forceinline__ unsigned xb_ld(unsigned* p)              { return __hip_atomic_load(p, __ATOMIC_RELAXED, __HIP_MEMORY_SCOPE_AGENT); }
__device__ __forceinline__ unsigned xb_add(unsigned* p, unsigned v) { return __hip_atomic_fetch_add(p, v, __ATOMIC_RELAXED, __HIP_MEMORY_SCOPE_AGENT); }
__device__ __forceinline__ unsigned xb_xcc_id() { return (unsigned)__builtin_amdgcn_s_getreg((3 << 11) | 20) & 0xFu; }
#define XB_SPIN(cond, bar) do { unsigned _sp = 0; while (cond) { __builtin_amdgcn_s_sleep(1); \
    if ((++_sp & 255u) == 0u) { if (xb_ld(&(bar)[XB_TMO])) break; if (_sp > XB_SPIN_CAP) { atomicAdd(&(bar)[XB_TMO], 1u); break; } } } } while (0)

struct XcdBarrier {
    unsigned* bar; unsigned x;
    volatile LAS unsigned* st;
};

__device__ __forceinline__ XcdBarrier xcd_barrier_post(unsigned* bar, volatile LAS unsigned* st) {
    XcdBarrier b; b.bar = bar; b.x = xb_xcc_id(); b.st = st;
    if (threadIdx.x == 0) (void)xb_add(&bar[XB_XCNT(b.x)], 1u);
    return b;
}
__device__ __forceinline__ void xcd_barrier_complete(unsigned* bar, unsigned x, unsigned& nloc, unsigned& nx) {
    const unsigned G = gridDim.x * gridDim.y * gridDim.z;
    unsigned sum, cnt, mine, sp = 0u;
    for (;;) {
        sum = 0u; cnt = 0u; mine = 0u;
#pragma unroll
        for (unsigned j = 0; j < 16; ++j) { const unsigned c = xb_ld(&bar[XB_XCNT(j)]); sum += c; cnt += (c > 0u) ? 1u : 0u; mine = (j == x) ? c : mine; }
        if (sum == G) break;
        __builtin_amdgcn_s_sleep(1);
        if ((++sp & 255u) == 0u) { if (xb_ld(&bar[XB_TMO])) break; if (sp > XB_SPIN_CAP) { atomicAdd(&bar[XB_TMO], 1u); break; } }
    }
    nloc = mine > 0u ? mine : 1u; nx = cnt > 0u ? cnt : 1u;
}

__device__ __forceinline__ void xcd_barrier(const XcdBarrier& b) {
    asm volatile("s_waitcnt vmcnt(0)" ::: "memory");
    __syncthreads();
    if (threadIdx.x == 0) {
        unsigned* bar = b.bar;
        __builtin_amdgcn_s_waitcnt(0);
        unsigned nloc = b.st[0], nx = b.st[1];
        if (nloc == 0u) { xcd_barrier_complete(bar, b.x, nloc, nx); b.st[0] = nloc; b.st[1] = nx; }
        const unsigned old = xb_add(&bar[XB_XSUB(b.x)], 1u);
        const unsigned gen = old / nloc;
        if (old + 1u == (gen + 1u) * nloc) {
            __builtin_amdgcn_fence(__ATOMIC_RELEASE, "agent");
            asm volatile("s_waitcnt vmcnt(0)" ::: "memory");
            const unsigned og = xb_add(&bar[XB_TOP], 1u);
            const unsigned tg = og / nx;
            if (og + 1u == (tg + 1u) * nx) xb_add(&bar[XB_TOPGEN], 1u);
            else XB_SPIN(xb_ld(&bar[XB_TOPGEN]) == tg, bar);
            __builtin_amdgcn_fence(__ATOMIC_ACQUIRE, "agent");
            xb_add(&bar[XB_XGEN(b.x)], 1u);
            asm volatile("s_waitcnt vmcnt(0)" ::: "memory");
        } else {
            XB_SPIN(xb_ld(&bar[XB_XGEN(b.x)]) == gen, bar);
            __builtin_amdgcn_fence(__ATOMIC_ACQUIRE, "agent");
            asm volatile("s_waitcnt vmcnt(0)" ::: "memory");
        }
    }
    __syncthreads();
}


constexpr int DM = 2048, NB = 4, SEQ = 8192, DEPTH = 4, DB = 8, DS = 64, PAST = 1024;
constexpr int MP = NB * SEQ, MS = DB * DS, M = MP + MS;
constexpr int KEYS_S = PAST + DS, KROWS = MP + DB * KEYS_S;
constexpr int QL = 512, KVL = 256, ROPE = 64, S5W = 1024, INAB = 1856, INABP = 2048;
constexpr int C_CQ = 0, C_CKV = 512, C_KR = 768, C_U = 832;
constexpr int NH = 8, QHD = 192, QW = NH * QHD, KVW = NH * 256;
constexpr int S5G = 64, S5N = 64, S5P = 16;
constexpr int RH = 8, RDK = 256, RDV = 512, INC = 12288, C_RQ = 0, C_RK = 2048, C_RV = 4096, C_RG = 8192;
constexpr int FF = 8192;
constexpr float EPS = 1e-6f, GN_EPS = 1e-5f;
constexpr int NWAVES = 8, NTHREADS = 512;

constexpr size_t O_Y = 0;
constexpr size_t O_CKV_P = (size_t)M * DM;
constexpr size_t O_KR_P = O_CKV_P + (size_t)2 * MP * KVL;
constexpr size_t O_S5RE_P = O_KR_P + (size_t)2 * MP * ROPE;
constexpr size_t O_S5IM_P = O_S5RE_P + (size_t)2 * NB * S5G * S5N;
constexpr size_t O_RET_P = O_S5IM_P + (size_t)2 * NB * S5G * S5N;
constexpr size_t O_CKV_S = O_RET_P + (size_t)2 * NB * RH * RDK * RDV;
constexpr size_t O_KR_S = O_CKV_S + (size_t)2 * MS * KVL;
constexpr size_t O_S5RE_S = O_KR_S + (size_t)2 * MS * ROPE;
constexpr size_t O_S5IM_S = O_S5RE_S + (size_t)2 * DB * S5G * S5N;
constexpr size_t O_RET_S = O_S5IM_S + (size_t)2 * DB * S5G * S5N;
constexpr size_t O_END = O_RET_S + (size_t)2 * DB * RH * RDK * RDV;
static_assert(O_END == 114819072, "d_out size");

constexpr size_t MiB = (size_t)1 << 20;
constexpr size_t WS_CTL = 0, CTL_ZERO_BYTES = 64 * 1024;
constexpr size_t WS_ROPE = 1 * MiB;
constexpr size_t WS_S5TAB = 9 * MiB, S5TAB_STRIDE = 1 * MiB;
constexpr size_t S5T_A = 0, S5T_B = 65536, S5T_C = 65536 + 262144;
constexpr size_t WS_S5CAR = 11 * MiB;
constexpr size_t WS_RSS = 27 * MiB, RSS_BANK = 256 * 1024, WS_RSSP = 27 * MiB + 512 * 1024;
static_assert(WS_RSSP + (size_t)M * 128 <= 32 * MiB, "rssp");
constexpr size_t WS_W = 32 * MiB, W_BUF = 0;
constexpr size_t W_UP = 0, W_DOWN = 32 * MiB, W_MIX = 64 * MiB;
constexpr size_t W_INAB = W_MIX, W_QB = W_MIX + 8 * MiB, W_KVB = W_MIX + 10 * MiB, W_GLU = W_MIX + 12 * MiB, W_OUTAB = W_MIX + 14 * MiB;
constexpr size_t W_INC = W_MIX, W_OUTC = W_MIX + 48 * MiB;
constexpr size_t WS_ACT = 160 * MiB;
constexpr size_t A_H = 0;
constexpr size_t A_FF = 130 * MiB;
constexpr size_t A_INAB = 130 * MiB, A_CQN = 260 * MiB, A_ACKV = 293 * MiB, A_AKR = 314 * MiB, A_Q = 320 * MiB, A_KV = 418 * MiB, A_MIX = 580 * MiB, A_Z = 710 * MiB;
constexpr size_t A_INC = 130 * MiB;
constexpr size_t A_PART = 840 * MiB;
constexpr size_t WS_END = WS_ACT + 910 * MiB;
static_assert(A_INAB + (size_t)M * INABP * 2 <= A_CQN && A_CQN + (size_t)M * QL * 2 <= A_ACKV && A_ACKV + (size_t)KROWS * KVL * 2 <= A_AKR && A_AKR + (size_t)KROWS * ROPE * 2 <= A_Q &&
              A_Q + (size_t)M * QW * 2 <= A_KV && A_KV + (size_t)KROWS * KVW * 2 <= A_MIX && A_MIX + (size_t)M * DM * 2 <= A_Z && A_Z + (size_t)M * S5W * 2 <= 910 * MiB &&
              A_INC + (size_t)M * INC * 2 <= 910 * MiB && A_FF + (size_t)M * FF * 2 <= 910 * MiB && (size_t)M * DM * 2 <= A_FF, "activation map");
constexpr int CW_BAR = 1024;
static_assert((CW_BAR + XCD_BAR_WORDS) * 4 <= (int)CTL_ZERO_BYTES, "ctl");

constexpr int LDS_MAIN = 139264;
constexpr int LDSCTL_OFF = LDS_MAIN;
constexpr int LDS_BYTES = 147456;

struct Args { const float* in[31]; float* out; unsigned char* ws; int ph_lo, ph_hi; };
struct Ctx { unsigned char* ws; float* out; };
template <class T> __device__ __forceinline__ T* as_global(T* p) { GAS T* g = (GAS T*)p; asm("" : "+s"(g)); return (T*)g; }
template <class T> __device__ __forceinline__ T* opaque(T* p) { GAS T* g = (GAS T*)p; asm volatile("" : "+s"(g)); return (T*)g; }
__device__ __forceinline__ const float* arg_in(int k) {
    int off = k * 8; asm volatile("" : "+s"(off));
    return as_global(*(const float* const __attribute__((address_space(4)))*)((const __attribute__((address_space(4))) char*)__builtin_amdgcn_kernarg_segment_ptr() + off));
}

__device__ __forceinline__ float wave_sum(float v) {
#define WS_SWZ(pat) v += __builtin_bit_cast(float, __builtin_amdgcn_ds_swizzle(__builtin_bit_cast(int, v), pat))
    WS_SWZ(0x041F); WS_SWZ(0x081F); WS_SWZ(0x101F); WS_SWZ(0x201F); WS_SWZ(0x401F);
#undef WS_SWZ
    const auto rr = __builtin_amdgcn_permlane32_swap(__float_as_uint(v), __float_as_uint(v), false, false);
    return __uint_as_float(rr[0]) + __uint_as_float(rr[1]);
}
#define LDS_WAIT() asm volatile("s_waitcnt lgkmcnt(0)" ::: "memory")
#define VM_WAIT() asm volatile("s_waitcnt vmcnt(0)" ::: "memory")

__device__ __forceinline__ void sincos_d(double a, double& s, double& c) {
    const double k = rint(a * 0.63661977236758134308);
    double y = fma(-k, 1.57079632679489655800, a); y = fma(-k, 6.123233995736766e-17, y);
    const double y2 = y * y;
    double sp = -7.6471637318198164759e-13; sp = fma(sp, y2, 1.6059043836821614599e-10); sp = fma(sp, y2, -2.5052108385441718775e-8); sp = fma(sp, y2, 2.7557319223985890653e-6);
    sp = fma(sp, y2, -1.9841269841269841270e-4); sp = fma(sp, y2, 8.3333333333333333333e-3); sp = fma(sp, y2, -1.6666666666666666667e-1); const double sy = fma(sp * y2, y, y);
    double cp = 4.7794773323873852974e-14; cp = fma(cp, y2, -1.1470745597729724714e-11); cp = fma(cp, y2, 2.0876756987868098979e-9); cp = fma(cp, y2, -2.7557319223985890653e-7);
    cp = fma(cp, y2, 2.4801587301587301587e-5); cp = fma(cp, y2, -1.3888888888888888889e-3); cp = fma(cp, y2, 4.1666666666666666667e-2); cp = fma(cp, y2, -0.5); const double cy = fma(cp, y2, 1.0);
    const int q = ((int)k) & 3;
    s = (q == 0) ? sy : (q == 1) ? cy : (q == 2) ? -sy : -cy;
    c = (q == 0) ? cy : (q == 1) ? -sy : (q == 2) ? -cy : sy;
}

__device__ __forceinline__ int row_pos(int m) { return m < MP ? (m & (SEQ - 1)) : PAST + ((m - MP) & (DS - 1)); }
__device__ __forceinline__ int row_key(int m) { return m < MP ? m : MP + ((m - MP) >> 6) * KEYS_S + PAST + ((m - MP) & (DS - 1)); }

__device__ __forceinline__ void ph_tables(const Ctx& a, int gthreads) {
    int tid_ = threadIdx.x; asm volatile("" : "+v"(tid_)); const int gtid = blockIdx.x * NTHREADS + tid_;
    f32x2* rope = (f32x2*)(a.ws + WS_ROPE);
    for (int e = gtid; e < SEQ * 128; e += gthreads) {
        const int pos = e >> 7, j = e & 127;
        const double inv = exp(-(double)j * (9.210340371976182736 / 128.0));
        double s, c; sincos_d((double)pos * inv, s, c);
        rope[e] = (f32x2){(float)c, (float)s};
    }
    for (int e = gtid; e < 2 * S5G * S5N; e += gthreads) {
        const int i = e >> 12, g = (e >> 6) & 63, n = e & 63;
        unsigned char* tab = a.ws + WS_S5TAB + (size_t)i * S5TAB_STRIDE;
        const double lr = fmin((double)arg_in(15)[e], -1e-4), li = (double)arg_in(16)[e];
        const double dt = exp((double)arg_in(17)[i * S5G + g]);
        const double mag = exp(lr * dt); double sn, cs; sincos_d(li * dt, sn, cs);
        const double are = mag * cs, aim = mag * sn, den = lr * lr + li * li;
        const double fre = ((are - 1.0) * lr + aim * li) / den, fim = (aim * lr - (are - 1.0) * li) / den;
        double pr = are, pi = aim;
#pragma unroll
        for (int k = 0; k < 6; ++k) { const double nr = pr * pr - pi * pi, ni = 2.0 * pr * pi; pr = nr; pi = ni; }
        ((f32x4*)(tab + S5T_A))[g * S5N + n] = (f32x4){(float)are, (float)aim, (float)pr, (float)pi};
        bf16_t* bbt = (bf16_t*)(tab + S5T_B); bf16_t* cmt = (bf16_t*)(tab + S5T_C);
        const float* bre = arg_in(18) + (size_t)e * S5P; const float* bim = arg_in(19) + (size_t)e * S5P;
        const float* cre = arg_in(20) + ((size_t)i * S5G + g) * S5P * S5N + n; const float* cim = arg_in(21) + ((size_t)i * S5G + g) * S5P * S5N + n;
        f32x4 brv[4], biv[4]; float crv[16], civ[16];
#pragma unroll
        for (int q = 0; q < 4; ++q) { brv[q] = *(const f32x4*)(bre + 4 * q); biv[q] = *(const f32x4*)(bim + 4 * q); }
#pragma unroll
        for (int p = 0; p < S5P; ++p) { crv[p] = cre[(size_t)p * S5N]; civ[p] = cim[(size_t)p * S5N]; }
#pragma unroll
        for (int p = 0; p < S5P; ++p) {
            const double br = brv[p >> 2][p & 3], bi = biv[p >> 2][p & 3];
            bbt[((size_t)g * 128 + n) * 16 + p] = f2bf((float)(fre * br - fim * bi));
            bbt[((size_t)g * 128 + 64 + n) * 16 + p] = f2bf((float)(fre * bi + fim * br));
            cmt[((size_t)g * 16 + p) * 128 + n] = f2bf(crv[p]);
            cmt[((size_t)g * 16 + p) * 128 + 64 + n] = f2bf(-civ[p]);
        }
    }
}

__device__ __forceinline__ int wrow_perm(int n, int pm) {
    if (pm == 1) return (n < 4096) ? ((n & ~255) | ((n & 127) << 1) | ((n >> 7) & 1)) : n;
    if (pm == 2) { const int h = n / 192, r = n - h * 192; return (r < 128) ? n : h * 192 + 128 + (((r - 128) & 31) << 1) + ((r - 128) >> 5); }
    return n;
}
__device__ __forceinline__ void transpose_item(const float* W, int K, int N, bf16_t* WT, LAS float* scr, int item, int lane, const float* gk, int pm) {
    const int nblk = N / 32, kb = item / nblk, nb = item % nblk, k0 = 64 * kb, n0 = 32 * nb;
#pragma unroll 8
    for (int i = 0; i < 32; ++i) { const int kk = 2 * i + (lane >> 5); scr[kk * 33 + (lane & 31)] = W[(size_t)(k0 + kk) * N + n0 + (lane & 31)]; }
    LDS_WAIT(); asm volatile("" ::: "memory");
    const int c = lane & 7;
    f32x4 g0 = {1.f, 1.f, 1.f, 1.f}, g1 = g0;
    if (gk) { g0 = *(const f32x4*)(gk + k0 + 8 * c); g1 = *(const f32x4*)(gk + k0 + 8 * c + 4); }
#pragma unroll
    for (int j = 0; j < 4; ++j) { const int n = (lane >> 3) + 8 * j; const LAS float* s = scr + (8 * c) * 33 + n;
        u32x4 o; o.x = cvt_pk_bf16(s[0 * 33] * g0.x, s[1 * 33] * g0.y); o.y = cvt_pk_bf16(s[2 * 33] * g0.z, s[3 * 33] * g0.w); o.z = cvt_pk_bf16(s[4 * 33] * g1.x, s[5 * 33] * g1.y); o.w = cvt_pk_bf16(s[6 * 33] * g1.z, s[7 * 33] * g1.w);
        const int nr = wrow_perm(n0 + n, pm);
        *(u32x4*)(WT + ((size_t)(nr >> 8) * (K >> 6) + (k0 >> 6)) * 16384 + (size_t)(nr & 255) * 64 + 8 * c) = o; }
    LDS_WAIT(); asm volatile("" ::: "memory");
}
__device__ __forceinline__ int convert_items(int L) { return 16384 + (((L & 1) == 0) ? (DM / 64) * (INAB / 32) + (QL / 64) * (QW / 32) + (KVL / 64) * (KVW / 32) + (S5W / 64) * (S5W / 32) + (DM / 64) * (DM / 32) : (DM / 64) * (INC / 32) + (4096 / 64) * (DM / 32)); }
__device__ __forceinline__ void ph_convert(const Ctx& a, int L, LAS unsigned char* lds, int i0, int i1, int pblk0, int G) {
    int tid_ = threadIdx.x; asm volatile("" : "+v"(tid_)); const int lane = tid_ & 63, wave = __builtin_amdgcn_readfirstlane(tid_ >> 6);
    if ((int)blockIdx.x < pblk0) return;
    const int gw = ((int)blockIdx.x - pblk0) * NWAVES + wave, NGW = (G - pblk0) * NWAVES;
    LAS float* scr = (LAS float*)(lds + wave * 16384);
    unsigned char* wb = a.ws + WS_W + (size_t)(L & 1) * W_BUF;
    const int i = L >> 1; const bool even = (L & 1) == 0;
    constexpr int I_UP = (DM / 64) * (FF / 32), I_DN = (FF / 64) * (DM / 32);
    constexpr int IE_IN = (DM / 64) * (INAB / 32), IE_QB = (QL / 64) * (QW / 32), IE_KVB = (KVL / 64) * (KVW / 32), IE_GLU = (S5W / 64) * (S5W / 32), IE_OUT = (DM / 64) * (DM / 32);
    constexpr int IO_IN = (DM / 64) * (INC / 32), IO_OUT = (4096 / 64) * (DM / 32);
    const int nit = I_UP + I_DN + (even ? IE_IN + IE_QB + IE_KVB + IE_GLU + IE_OUT : IO_IN + IO_OUT);
    const int iend = i1 < nit ? i1 : nit;
    for (int it = i0 + gw; it < iend; it += NGW) {
        int r = it; const float* W; int K, N; size_t wo; const float* gk = nullptr; int pm = 0;
        if (r < I_UP) { W = arg_in(29) + (size_t)L * DM * FF; K = DM; N = FF; wo = W_UP; gk = arg_in(8) + L * DM; }
        else if ((r -= I_UP) < I_DN) { W = arg_in(30) + (size_t)L * FF * DM; K = FF; N = DM; wo = W_DOWN; }
        else if (even) {
            r -= I_DN;
            if (r < IE_IN) { W = arg_in(10) + (size_t)i * DM * INAB; K = DM; N = INAB; wo = W_INAB; gk = arg_in(7) + L * DM; }
            else if ((r -= IE_IN) < IE_QB) { W = arg_in(13) + (size_t)i * QL * QW; K = QL; N = QW; wo = W_QB; pm = 2; }
            else if ((r -= IE_QB) < IE_KVB) { W = arg_in(14) + (size_t)i * KVL * KVW; K = KVL; N = KVW; wo = W_KVB; }
            else if ((r -= IE_KVB) < IE_GLU) { W = arg_in(23) + (size_t)i * S5W * S5W; K = S5W; N = S5W; wo = W_GLU; }
            else { r -= IE_GLU; W = arg_in(25) + (size_t)i * DM * DM; K = DM; N = DM; wo = W_OUTAB; }
        } else {
            r -= I_DN;
            if (r < IO_IN) { W = arg_in(26) + (size_t)i * DM * INC; K = DM; N = INC; wo = W_INC; gk = arg_in(7) + L * DM; pm = 1; }
            else { r -= IO_IN; W = arg_in(28) + (size_t)i * 4096 * DM; K = 4096; N = DM; wo = W_OUTC; }
        }
        transpose_item(W, K, N, (bf16_t*)(wb + wo), scr, r, lane, gk, pm);
    }
    if (even && i1 >= nit) {
        unsigned zz = 0u; asm volatile("" : "+v"(zz));
        constexpr int NCH = (INABP - INAB) * DM / 8;
        for (int e = gw * 64 + lane; e < NCH; e += NGW * 64) { const int nr = INAB + e / (DM / 8), k = (e % (DM / 8)) * 8;
            *(u32x4*)((bf16_t*)(wb + W_INAB) + ((size_t)(nr >> 8) * (DM >> 6) + (k >> 6)) * 16384 + (size_t)(nr & 255) * 64 + (k & 63)) = (u32x4){zz, zz, zz, zz}; }
    }
}


__device__ __forceinline__ void add_slabs(f32x4 (&v)[8], const float* part, int ns, int ms, int lane) {
    const float* pr = part + (size_t)ms * DM + 4 * lane;
    for (int sl = 0; sl < ns; sl += 4) {
        f32x4 t[4][8];
#pragma unroll
        for (int q = 0; q < 4; ++q)
#pragma unroll
            for (int j = 0; j < 8; ++j) t[q][j] = *(const f32x4*)(pr + (size_t)(sl + q) * MS * DM + 256 * j);
        __builtin_amdgcn_sched_barrier(0);
#pragma unroll
        for (int j = 0; j < 8; ++j) v[j] += (t[0][j] + t[1][j]) + (t[2][j] + t[3][j]);
        __builtin_amdgcn_sched_barrier(0);
    }
}
__device__ __forceinline__ void ph_xprep(const float* xp, const float* xs_adj, bf16_t* XB, float* RSS, int r0, int r1, int NGW, const float* part, int ns, float* xw, const float* rssp) {
    int tid_ = threadIdx.x; asm volatile("" : "+v"(tid_)); const int lane = tid_ & 63, wave = __builtin_amdgcn_readfirstlane(tid_ >> 6), gw = blockIdx.x * NWAVES + wave;
    if (rssp != nullptr)
        for (int m = blockIdx.x * NTHREADS + tid_; m < MP; m += gridDim.x * NTHREADS) { const f32x4* p = (const f32x4*)(rssp + (size_t)m * 32); f32x4 a = p[0];
#pragma unroll
            for (int j = 1; j < 8; ++j) a += p[j];
            RSS[m] = (a.x + a.y) + (a.z + a.w); }
    f32x4 vn[8];
    if (r0 + gw < r1) { const int m = r0 + gw; const float* xr = ((m < MP) ? xp : xs_adj) + (size_t)m * DM;
#pragma unroll
        for (int j = 0; j < 8; ++j) vn[j] = *(const f32x4*)(xr + 4 * lane + 256 * j); }
    for (int m = r0 + gw; m < r1; m += NGW) {
        f32x4 v[8]; float s = 0.f;
#pragma unroll
        for (int j = 0; j < 8; ++j) v[j] = vn[j];
        if (m + NGW < r1) { const int mn = m + NGW; const float* xr = ((mn < MP) ? xp : xs_adj) + (size_t)mn * DM;
#pragma unroll
            for (int j = 0; j < 8; ++j) vn[j] = *(const f32x4*)(xr + 4 * lane + 256 * j); }
        if (part != nullptr && m >= MP) {
            add_slabs(v, part, ns, m - MP, lane);
#pragma unroll
            for (int j = 0; j < 8; ++j) *(f32x4*)(xw + (size_t)m * DM + 4 * lane + 256 * j) = v[j];
        }
#pragma unroll
        for (int j = 0; j < 8; ++j) { s += (v[j].x * v[j].x + v[j].y * v[j].y) + (v[j].z * v[j].z + v[j].w * v[j].w);
            *(u32x2*)(XB + (size_t)m * DM + 4 * lane + 256 * j) = (u32x2){cvt_pk_bf16(v[j].x, v[j].y), cvt_pk_bf16(v[j].z, v[j].w)}; }
        s = wave_sum(s);
        if (lane == 0) RSS[m] = s;
    }
}

__device__ __forceinline__ void ph_xprep_samp(float* X, bf16_t* XB, float* RSS, const float* part, int ns, LAS float* red) {
    int tid_ = threadIdx.x; asm volatile("" : "+v"(tid_)); const int lane = tid_ & 63, wave = __builtin_amdgcn_readfirstlane(tid_ >> 6);
    __syncthreads();
    for (int rp = blockIdx.x; rp < MS / 2; rp += gridDim.x) {
        const int ms = 2 * rp + (wave >> 2), q = wave & 3, m = MP + ms; const size_t off = (size_t)m * DM + q * 512 + 4 * lane;
        f32x4 v[2] = {*(const f32x4*)(X + off), *(const f32x4*)(X + off + 256)};
        const float* pr = part + (size_t)ms * DM + q * 512 + 4 * lane;
        if (ns == 16) { f32x4 t[16][2];
#pragma unroll
            for (int sl = 0; sl < 16; ++sl) { t[sl][0] = *(const f32x4*)(pr + (size_t)sl * MS * DM); t[sl][1] = *(const f32x4*)(pr + (size_t)sl * MS * DM + 256); }
            __builtin_amdgcn_sched_barrier(0);
#pragma unroll
            for (int sl = 0; sl < 16; sl += 4) { v[0] += (t[sl][0] + t[sl + 1][0]) + (t[sl + 2][0] + t[sl + 3][0]); v[1] += (t[sl][1] + t[sl + 1][1]) + (t[sl + 2][1] + t[sl + 3][1]); } }
        else { f32x4 t[8][2];
#pragma unroll
            for (int sl = 0; sl < 8; ++sl) { t[sl][0] = *(const f32x4*)(pr + (size_t)sl * MS * DM); t[sl][1] = *(const f32x4*)(pr + (size_t)sl * MS * DM + 256); }
            __builtin_amdgcn_sched_barrier(0);
#pragma unroll
            for (int sl = 0; sl < 8; sl += 4) { v[0] += (t[sl][0] + t[sl + 1][0]) + (t[sl + 2][0] + t[sl + 3][0]); v[1] += (t[sl][1] + t[sl + 1][1]) + (t[sl + 2][1] + t[sl + 3][1]); } }
        float s = 0.f;
#pragma unroll
        for (int j = 0; j < 2; ++j) { *(f32x4*)(X + off + 256 * j) = v[j];
            *(u32x2*)(XB + off + 256 * j) = (u32x2){cvt_pk_bf16(v[j].x, v[j].y), cvt_pk_bf16(v[j].z, v[j].w)};
            s += (v[j].x * v[j].x + v[j].y * v[j].y) + (v[j].z * v[j].z + v[j].w * v[j].w); }
        s = wave_sum(s);
        if (lane == 0) red[wave] = s;
        __syncthreads();
        if ((wave & 3) == 0 && lane == 0) RSS[m] = (red[wave] + red[wave + 1]) + (red[wave + 2] + red[wave + 3]);
        __syncthreads();
    }
}
__device__ __forceinline__ void zero_f32(float* p, int n) {
    int tid_ = threadIdx.x; asm volatile("" : "+v"(tid_));
    for (int e = blockIdx.x * NTHREADS + tid_; e < n; e += gridDim.x * NTHREADS) p[e] = 0.f;
}
template <bool OUT_F32>
__device__ __forceinline__ void ph_rmsnorm(const float* xp, const float* xs_adj, const float* gain, bf16_t* H, float* outf, int NGW, const float* part = nullptr, int ns = 0, float* xw = nullptr, const bf16_t* xb = nullptr) {
    int tid_ = threadIdx.x; asm volatile("" : "+v"(tid_)); const int lane = tid_ & 63, wave = __builtin_amdgcn_readfirstlane(tid_ >> 6), gw = blockIdx.x * NWAVES + wave; (void)wave;
    f32x4 g[8];
#pragma unroll
    for (int j = 0; j < 8; ++j) g[j] = *(const f32x4*)(gain + 4 * lane + 256 * j);
    u32x2 wn[8];
    if (xb != nullptr && gw < MP) {
#pragma unroll
        for (int j = 0; j < 8; ++j) wn[j] = *(const u32x2*)(xb + (size_t)gw * DM + 4 * lane + 256 * j); }
    for (int m = gw; m < M; m += NGW) {
        const float* xr = ((m < MP) ? xp : xs_adj) + (size_t)m * DM;
        f32x4 v[8]; float s = 0.f;
        if (xb != nullptr && m < MP) {
#pragma unroll
            for (int j = 0; j < 8; ++j) v[j] = (f32x4){bf_lo(wn[j].x), bf_hi(wn[j].x), bf_lo(wn[j].y), bf_hi(wn[j].y)}; }
        else {
#pragma unroll
            for (int j = 0; j < 8; ++j) v[j] = *(const f32x4*)(xr + 4 * lane + 256 * j); }
        if (xb != nullptr && m + NGW < MP) {
#pragma unroll
            for (int j = 0; j < 8; ++j) wn[j] = *(const u32x2*)(xb + (size_t)(m + NGW) * DM + 4 * lane + 256 * j); }
        if (part != nullptr && m >= MP) {
            add_slabs(v, part, ns, m - MP, lane);
#pragma unroll
            for (int j = 0; j < 8; ++j) *(f32x4*)(xw + (size_t)m * DM + 4 * lane + 256 * j) = v[j];
        }
#pragma unroll
        for (int j = 0; j < 8; ++j) { s += (v[j].x * v[j].x + v[j].y * v[j].y) + (v[j].z * v[j].z + v[j].w * v[j].w); }
        const float rstd = 1.0f / sqrtf(wave_sum(s) * (1.0f / DM) + EPS);
#pragma unroll
        for (int j = 0; j < 8; ++j) {
            const f32x4 y = v[j] * rstd * g[j];
            if (OUT_F32) *(f32x4*)(outf + (size_t)m * DM + 4 * lane + 256 * j) = y;
            else *(u32x2*)(H + (size_t)m * DM + 4 * lane + 256 * j) = (u32x2){cvt_pk_bf16(y.x, y.y), cvt_pk_bf16(y.z, y.w)};
        }
    }
}

__device__ __forceinline__ void ph_mla_post(const Ctx& a, int i, int NGW) {
    int tid_ = threadIdx.x; asm volatile("" : "+v"(tid_)); const int lane = tid_ & 63, wave = __builtin_amdgcn_readfirstlane(tid_ >> 6), gw = blockIdx.x * NWAVES + wave; (void)wave;
    const bf16_t* INB = (const bf16_t*)(a.ws + WS_ACT + A_INAB);
    bf16_t* CQN = (bf16_t*)(a.ws + WS_ACT + A_CQN); bf16_t* ACKV = (bf16_t*)(a.ws + WS_ACT + A_ACKV); bf16_t* AKR = (bf16_t*)(a.ws + WS_ACT + A_AKR);
    const f32x2* rope = (const f32x2*)(a.ws + WS_ROPE);
    const float* qg = arg_in(11) + i * QL; const float* kg = arg_in(12) + i * KVL;
    f32x4 qg0 = *(const f32x4*)(qg + 8 * lane), qg1 = *(const f32x4*)(qg + 8 * lane + 4), kg0 = *(const f32x4*)(kg + 4 * lane);
    struct RowIn { u32x4 cq; u32x2 ck; unsigned short x1h, x2h; f32x2 cs; };
    auto load_row = [&](int m, RowIn& o) { const bf16_t* r = INB + (size_t)m * INABP;
        o.cq = *(const u32x4*)(r + C_CQ + 8 * lane); o.ck = *(const u32x2*)(r + C_CKV + 4 * lane);
        o.x1h = r[C_KR + (lane & 31)]; o.x2h = r[C_KR + 32 + (lane & 31)]; o.cs = rope[(size_t)row_pos(m) * 128 + 4 * (lane & 31)]; };
    RowIn nx; if (gw < M) load_row(gw, nx);
    for (int m = gw; m < M + DB * PAST; m += NGW) {
        if (m < M) {
            const RowIn cu = nx; if (m + NGW < M) load_row(m + NGW, nx);
            const u32x4 cq = cu.cq; const u32x2 ck = cu.ck; const unsigned short x1h = cu.x1h, x2h = cu.x2h; const f32x2 cs = cu.cs;
            const int kr = row_key(m);
            float q[8] = {bf_lo(cq.x), bf_hi(cq.x), bf_lo(cq.y), bf_hi(cq.y), bf_lo(cq.z), bf_hi(cq.z), bf_lo(cq.w), bf_hi(cq.w)};
            float k[4] = {bf_lo(ck.x), bf_hi(ck.x), bf_lo(ck.y), bf_hi(ck.y)};
            float sq = 0.f, sk = 0.f;
#pragma unroll
            for (int j = 0; j < 8; ++j) sq += q[j] * q[j];
#pragma unroll
            for (int j = 0; j < 4; ++j) sk += k[j] * k[j];
            const float rq = 1.0f / sqrtf(wave_sum(sq) * (1.0f / QL) + EPS), rk = 1.0f / sqrtf(wave_sum(sk) * (1.0f / KVL) + EPS);
            u32x4 oq; oq.x = cvt_pk_bf16(q[0] * rq * qg0.x, q[1] * rq * qg0.y); oq.y = cvt_pk_bf16(q[2] * rq * qg0.z, q[3] * rq * qg0.w);
            oq.z = cvt_pk_bf16(q[4] * rq * qg1.x, q[5] * rq * qg1.y); oq.w = cvt_pk_bf16(q[6] * rq * qg1.z, q[7] * rq * qg1.w);
            *(u32x4*)(CQN + (size_t)m * QL + 8 * lane) = oq;
            const f32x4 ko = (f32x4){k[0] * rk * kg0.x, k[1] * rk * kg0.y, k[2] * rk * kg0.z, k[3] * rk * kg0.w};
            float* ckv_out = (m < MP) ? a.out + O_CKV_P + ((size_t)i * MP + m) * KVL : a.out + O_CKV_S + ((size_t)i * MS + (m - MP)) * KVL;
            *(f32x4*)(ckv_out + 4 * lane) = ko;
            *(u32x2*)(ACKV + (size_t)kr * KVL + 4 * lane) = (u32x2){cvt_pk_bf16(ko.x, ko.y), cvt_pk_bf16(ko.z, ko.w)};
            if (lane < 32) {
                const float x1 = bf2f(x1h), x2 = bf2f(x2h);
                const float o1 = x1 * cs.x - x2 * cs.y, o2 = x1 * cs.y + x2 * cs.x;
                float* kr_out = (m < MP) ? a.out + O_KR_P + ((size_t)i * MP + m) * ROPE : a.out + O_KR_S + ((size_t)i * MS + (m - MP)) * ROPE;
                kr_out[lane] = o1; kr_out[32 + lane] = o2;
                *(unsigned*)(AKR + (size_t)kr * ROPE + 2 * lane) = cvt_pk_bf16(o1, o2);
            }
        } else {
            const int idx = m - M, b = idx >> 10, p = idx & (PAST - 1), kr = MP + b * KEYS_S + p;
            const f32x4 v = *(const f32x4*)(arg_in(2) + (((size_t)i * DB + b) * PAST + p) * KVL + 4 * lane);
            *(u32x2*)(ACKV + (size_t)kr * KVL + 4 * lane) = (u32x2){cvt_pk_bf16(v.x, v.y), cvt_pk_bf16(v.z, v.w)};
            if (lane < 32) { const float* kp = arg_in(3) + (((size_t)i * DB + b) * PAST + p) * ROPE;
                *(unsigned*)(AKR + (size_t)kr * ROPE + 2 * lane) = cvt_pk_bf16(kp[lane], kp[32 + lane]); }
        }
    }
}

__device__ __forceinline__ void ph_q_rope(const Ctx& a, int NGW, bool st = true) {
    int tid_ = threadIdx.x; asm volatile("" : "+v"(tid_)); const int lane = tid_ & 63, wave = __builtin_amdgcn_readfirstlane(tid_ >> 6), gw = blockIdx.x * NWAVES + wave; (void)wave;
    bf16_t* Q = (bf16_t*)(a.ws + WS_ACT + A_Q); const f32x2* rope = (const f32x2*)(a.ws + WS_ROPE);
    const int h = lane >> 3, j0 = 4 * (lane & 7);
    for (int m = gw; m < M; m += NGW) {
        bf16_t* p1 = Q + (size_t)m * QW + h * QHD + 128 + j0; bf16_t* p2 = p1 + 32;
        const u32x2 a1 = *(const u32x2*)p1, a2 = *(const u32x2*)p2;
        const float x1[4] = {bf_lo(a1.x), bf_hi(a1.x), bf_lo(a1.y), bf_hi(a1.y)}, x2[4] = {bf_lo(a2.x), bf_hi(a2.x), bf_lo(a2.y), bf_hi(a2.y)};
        const f32x2* cs = rope + (size_t)row_pos(m) * 128 + 4 * j0;
        float o1[4], o2[4];
#pragma unroll
        for (int k = 0; k < 4; ++k) { const f32x2 c = cs[4 * k]; o1[k] = x1[k] * c.x - x2[k] * c.y; o2[k] = x1[k] * c.y + x2[k] * c.x; }
        if (st) { *(u32x2*)p1 = (u32x2){cvt_pk_bf16(o1[0], o1[1]), cvt_pk_bf16(o1[2], o1[3])};
        *(u32x2*)p2 = (u32x2){cvt_pk_bf16(o2[0], o2[1]), cvt_pk_bf16(o2[2], o2[3])}; }
        else if (o1[0] == 1.2345e30f) p1[0] = 0;
    }
}

__device__ __forceinline__ void ph_qk_rope(const Ctx& a, int NGW, bool st = true) {
    int tid_ = threadIdx.x; asm volatile("" : "+v"(tid_)); const int lane = tid_ & 63, wave = __builtin_amdgcn_readfirstlane(tid_ >> 6), gw = blockIdx.x * NWAVES + wave; (void)wave;
    bf16_t* X = (bf16_t*)(a.ws + WS_ACT + A_INC); const f32x2* rope = (const f32x2*)(a.ws + WS_ROPE);
    for (int m = gw; m < M; m += NGW) {
        const f32x2* cs0 = rope + (size_t)row_pos(m) * 128;
#pragma unroll
        for (int it = 0; it < 4; ++it) {
            const int e = it * 64 + lane, th = e >> 4, j0 = (e & 15) * 8;
            bf16_t* p1 = X + (size_t)m * INC + th * 256 + j0; bf16_t* p2 = p1 + 128;
            const u32x4 a1 = *(const u32x4*)p1, a2 = *(const u32x4*)p2;
            const float x1[8] = {bf_lo(a1.x), bf_hi(a1.x), bf_lo(a1.y), bf_hi(a1.y), bf_lo(a1.z), bf_hi(a1.z), bf_lo(a1.w), bf_hi(a1.w)};
            const float x2[8] = {bf_lo(a2.x), bf_hi(a2.x), bf_lo(a2.y), bf_hi(a2.y), bf_lo(a2.z), bf_hi(a2.z), bf_lo(a2.w), bf_hi(a2.w)};
            const float sc = (th >= 8) ? 0.0625f : 1.0f;
            float o1[8], o2[8];
#pragma unroll
            for (int k = 0; k < 4; ++k) { const f32x4 c2 = *(const f32x4*)(cs0 + j0 + 2 * k);
                o1[2 * k] = (x1[2 * k] * c2.x - x2[2 * k] * c2.y) * sc; o2[2 * k] = (x1[2 * k] * c2.y + x2[2 * k] * c2.x) * sc;
                o1[2 * k + 1] = (x1[2 * k + 1] * c2.z - x2[2 * k + 1] * c2.w) * sc; o2[2 * k + 1] = (x1[2 * k + 1] * c2.w + x2[2 * k + 1] * c2.z) * sc; }
            if (st) { *(u32x4*)p1 = (u32x4){cvt_pk_bf16(o1[0], o1[1]), cvt_pk_bf16(o1[2], o1[3]), cvt_pk_bf16(o1[4], o1[5]), cvt_pk_bf16(o1[6], o1[7])};
            *(u32x4*)p2 = (u32x4){cvt_pk_bf16(o2[0], o2[1]), cvt_pk_bf16(o2[2], o2[3]), cvt_pk_bf16(o2[4], o2[5]), cvt_pk_bf16(o2[6], o2[7])}; }
            else if (o1[0] == 1.2345e30f) p1[0] = 0;
        }
    }
}

__device__ __forceinline__ void ph_gn_gate(const Ctx& a, int i, int NGW) {
    int tid_ = threadIdx.x; asm volatile("" : "+v"(tid_)); const int lane = tid_ & 63, wave = __builtin_amdgcn_readfirstlane(tid_ >> 6), gw = blockIdx.x * NWAVES + wave;
    bf16_t* X = (bf16_t*)(a.ws + WS_ACT + A_INC);
    const float* gnb = arg_in(27) + (size_t)i * RH * RDV + 8 * lane;
    const int h0 = gw & 7; const f32x4 g0 = *(const f32x4*)(gnb + h0 * RDV), g1 = *(const f32x4*)(gnb + h0 * RDV + 4); const float gg[8] = {g0.x, g0.y, g0.z, g0.w, g1.x, g1.y, g1.z, g1.w};
    constexpr int U = 4;
    u32x4 no[U], ng[U];
    auto load_round = [&](int it0) {
#pragma unroll
        for (int u = 0; u < U; ++u) { const int it = it0 + u * NGW; const int itc = (it < M * RH) ? it : it0; const int m = itc >> 3, h = itc & 7;
            const bf16_t* po = X + (size_t)m * INC + C_RV + h * RDV + 8 * lane; no[u] = *(const u32x4*)po; ng[u] = *(const u32x4*)(po + (C_RG - C_RV)); } };
    if (gw < M * RH) load_round(gw);
    for (int it0 = gw; it0 < M * RH; it0 += U * NGW) {
        u32x4 ao[U], ag[U]; bool ok[U];
#pragma unroll
        for (int u = 0; u < U; ++u) { ao[u] = no[u]; ag[u] = ng[u]; ok[u] = it0 + u * NGW < M * RH; }
        if (it0 + U * NGW < M * RH) load_round(it0 + U * NGW);
#pragma unroll
        for (int u = 0; u < U; ++u) { const int it = it0 + u * NGW; const int itc = ok[u] ? it : it0; const int m = itc >> 3, h = itc & 7;
            const float o[8] = {bf_lo(ao[u].x), bf_hi(ao[u].x), bf_lo(ao[u].y), bf_hi(ao[u].y), bf_lo(ao[u].z), bf_hi(ao[u].z), bf_lo(ao[u].w), bf_hi(ao[u].w)};
            const float g[8] = {bf_lo(ag[u].x), bf_hi(ag[u].x), bf_lo(ag[u].y), bf_hi(ag[u].y), bf_lo(ag[u].z), bf_hi(ag[u].z), bf_lo(ag[u].w), bf_hi(ag[u].w)};
            float s = 0.f;
#pragma unroll
            for (int k = 0; k < 8; ++k) s += o[k];
            const float mu = wave_sum(s) * (1.0f / RDV); float q = 0.f;
#pragma unroll
            for (int k = 0; k < 8; ++k) { const float d = o[k] - mu; q += d * d; }
            const float rstd = 1.0f / sqrtf(wave_sum(q) * (1.0f / RDV) + GN_EPS);
            float r[8];
#pragma unroll
            for (int k = 0; k < 8; ++k) r[k] = (o[k] - mu) * rstd * gg[k] * (g[k] / (1.0f + __expf(-g[k])));
            if (ok[u]) *(u32x4*)(X + (size_t)m * INC + C_RV + h * RDV + 8 * lane) = (u32x4){cvt_pk_bf16(r[0], r[1]), cvt_pk_bf16(r[2], r[3]), cvt_pk_bf16(r[4], r[5]), cvt_pk_bf16(r[6], r[7])};
        }
    }
}

constexpr int S5_PITCH = 132;
constexpr int S5_WAVE_BYTES = 32 * S5_PITCH * 4;
static_assert(NWAVES * S5_WAVE_BYTES <= LDS_MAIN, "S5 LDS");
__device__ __forceinline__ float gelu_tanh(float x) {
    const float u = 0.7978845608028654f * (x + 0.044715f * x * x * x);
    const float e = __expf(2.0f * u);
    const float t = 1.0f - 2.0f / (e + 1.0f);
    return 0.5f * x * (1.0f + t);
}
template <int PASS>
__device__ __forceinline__ void ph_s5(const Ctx& a, int i, LAS unsigned char* lds, int NGW, size_t zoff = A_Z) {
    int tid_ = threadIdx.x; asm volatile("" : "+v"(tid_)); const int lane = tid_ & 63, wave = __builtin_amdgcn_readfirstlane(tid_ >> 6), gw = blockIdx.x * NWAVES + wave;
    const unsigned char* tab = a.ws + WS_S5TAB + (size_t)i * S5TAB_STRIDE;
    const f32x4* atab = (const f32x4*)(tab + S5T_A); const bf16_t* bbt = (const bf16_t*)(tab + S5T_B); const bf16_t* cmt = (const bf16_t*)(tab + S5T_C);
    const bf16_t* INB = (const bf16_t*)(a.ws + WS_ACT + A_INAB); bf16_t* Z = (bf16_t*)(a.ws + WS_ACT + zoff);
    float* car = (float*)(a.ws + WS_S5CAR);
    const float* in_sre = arg_in(4); const float* in_sim = arg_in(5); const float* in_d = arg_in(22);
    LAS float* T = (LAS float*)(lds + wave * S5_WAVE_BYTES);
    const int r32 = lane & 31, hi = lane >> 5, l15 = lane & 15, kg = lane >> 4;
    constexpr int NU_P = NB * (S5G / 4) * (SEQ / 64), NU_S = DB * (S5G / 4);
    const int nunits = (PASS == 0) ? NU_P : NU_P + NU_S;
    struct Ops { bf16x8 ua[2], bb[4], cb[4]; f32x4 av; float sre, sim; f32x4 dskv; u32x2 uvq[2][2]; int b, g, c, row0; bool samp; };
    auto load_ops = [&](int u4, Ops& o) {
        const int u = u4 >> 2, gi = u4 & 3;
        int b, g, c, row0; bool samp = false;
        if (u < NU_P) { c = u & 127; g = ((u >> 7) & 15) * 4 + gi; b = u >> 11; row0 = b * SEQ + c * 64; }
        else { const int v = u - NU_P; samp = true; c = 0; g = (v & 15) * 4 + gi; b = v >> 4; row0 = MP + b * DS; }
        o.b = b; o.g = g; o.c = c; o.row0 = row0; o.samp = samp;
#pragma unroll
        for (int tt = 0; tt < 2; ++tt) o.ua[tt] = *(const bf16x8*)(INB + (size_t)(row0 + tt * 32 + r32) * INABP + C_U + 16 * g + 8 * hi);
#pragma unroll
        for (int nt = 0; nt < 4; ++nt) o.bb[nt] = *(const bf16x8*)(bbt + ((size_t)g * 128 + 32 * nt + r32) * 16 + 8 * hi);
        o.av = atab[g * S5N + lane];
        o.sre = 0.f; o.sim = 0.f; o.dskv = (f32x4){0.f, 0.f, 0.f, 0.f};
        if (PASS == 1) {
            const float* pre = samp ? in_sre + (((size_t)i * DB + b) * S5G + g) * S5N : car + (((size_t)b * S5G + g) * 128 + c) * 128;
            const float* pim = samp ? in_sim + (((size_t)i * DB + b) * S5G + g) * S5N : car + (((size_t)b * S5G + g) * 128 + c) * 128 + 64;
            o.sre = pre[lane]; o.sim = pim[lane];
#pragma unroll
            for (int ks = 0; ks < 4; ++ks) o.cb[ks] = *(const bf16x8*)(cmt + ((size_t)g * 16 + l15) * 128 + 32 * ks + 8 * kg);
            o.dskv = *(const f32x4*)(in_d + ((size_t)i * S5G + g) * S5P + 4 * kg);
#pragma unroll
            for (int tt = 0; tt < 2; ++tt)
#pragma unroll
                for (int t16 = 0; t16 < 2; ++t16)
                    o.uvq[tt][t16] = *(const u32x2*)(INB + (size_t)(row0 + tt * 32 + t16 * 16 + l15) * INABP + C_U + 16 * g + 4 * kg);
        }
    };
    int u4 = gw * 4;
    if (u4 >= nunits * 4) return;
    Ops nx; load_ops(u4, nx);
    for (;;) {
        const Ops cu = nx;
        const int u4n = ((u4 & 3) == 3) ? u4 - 3 + NGW * 4 : u4 + 1; const bool has_next = u4n < nunits * 4;
        if (has_next) load_ops(u4n, nx);
        const int b = cu.b, g = cu.g, c = cu.c, row0 = cu.row0; const bool samp = cu.samp;
        const bf16x8 ua[2] = {cu.ua[0], cu.ua[1]}; const bf16x8 bb[4] = {cu.bb[0], cu.bb[1], cu.bb[2], cu.bb[3]}; const bf16x8 cb[4] = {cu.cb[0], cu.cb[1], cu.cb[2], cu.cb[3]};
        const f32x4 av = cu.av; float sre = cu.sre, sim = cu.sim; const f32x4 dskv = cu.dskv;
#pragma unroll
        for (int tt = 0; tt < 2; ++tt) {
#pragma unroll
            for (int nt = 0; nt < 4; ++nt) {
                f32x16 acc = {}; acc = __builtin_amdgcn_mfma_f32_32x32x16_bf16(bb[nt], ua[tt], acc, 0, 0, 0);
#pragma unroll
                for (int q = 0; q < 4; ++q) *(LAS f32x4*)(T + r32 * S5_PITCH + 32 * nt + 8 * q + 4 * hi) = (f32x4){acc[4 * q], acc[4 * q + 1], acc[4 * q + 2], acc[4 * q + 3]};
            }
            LDS_WAIT(); asm volatile("" ::: "memory");
#pragma unroll 8
            for (int t = 0; t < 32; ++t) {
                const float bre = T[t * S5_PITCH + lane], bim = T[t * S5_PITCH + 64 + lane];

                float nre = __builtin_fmaf(av.x, sre, bre); asm volatile("" : "+v"(nre));
                float nim = __builtin_fmaf(av.x, sim, bim); asm volatile("" : "+v"(nim));
                nre = __builtin_fmaf(-av.y, sim, nre); asm volatile("" : "+v"(nre));
                nim = __builtin_fmaf(av.y, sre, nim); asm volatile("" : "+v"(nim));

                sre = nre; sim = nim;
                if (PASS == 1) { T[t * S5_PITCH + lane] = nre; T[t * S5_PITCH + 64 + lane] = nim; }
            }
            if (PASS == 1) {
                LDS_WAIT(); asm volatile("" ::: "memory");
#pragma unroll
                for (int t16 = 0; t16 < 2; ++t16) {
                    f32x4 y = {0.f, 0.f, 0.f, 0.f};
#pragma unroll
                    for (int ks = 0; ks < 4; ++ks) {
                        const LAS float* sp = T + (t16 * 16 + l15) * S5_PITCH + 32 * ks + 8 * kg;
                        const f32x4 s0 = *(const LAS f32x4*)sp, s1 = *(const LAS f32x4*)(sp + 4);
                        u32x4 w = {cvt_pk_bf16(s0.x, s0.y), cvt_pk_bf16(s0.z, s0.w), cvt_pk_bf16(s1.x, s1.y), cvt_pk_bf16(s1.z, s1.w)};
                        y = __builtin_amdgcn_mfma_f32_16x16x32_bf16(cb[ks], __builtin_bit_cast(bf16x8, w), y, 0, 0, 0);
                    }
                    { const u32x2 q = cu.uvq[tt][t16]; const float uvf[4] = {bf_lo(q.x), bf_hi(q.x), bf_lo(q.y), bf_hi(q.y)}; float z[4];
#pragma unroll
                        for (int r = 0; r < 4; ++r) z[r] = gelu_tanh(y[r] + dskv[r] * uvf[r]);
                        *(u32x2*)(Z + (size_t)(row0 + tt * 32 + t16 * 16 + l15) * S5W + 16 * g + 4 * kg) = (u32x2){cvt_pk_bf16(z[0], z[1]), cvt_pk_bf16(z[2], z[3])}; }
                }
                LDS_WAIT(); asm volatile("" ::: "memory");
            }
        }
        if (PASS == 0) { float* cp = car + (((size_t)b * S5G + g) * 128 + c) * 128;
            cp[lane] = sre; cp[64 + lane] = sim; }
        else if (samp || c == 127) {
            float* ore = samp ? a.out + O_S5RE_S + (((size_t)i * DB + b) * S5G + g) * S5N : a.out + O_S5RE_P + (((size_t)i * NB + b) * S5G + g) * S5N;
            float* oim = samp ? a.out + O_S5IM_S + (((size_t)i * DB + b) * S5G + g) * S5N : a.out + O_S5IM_P + (((size_t)i * NB + b) * S5G + g) * S5N;
            ore[lane] = sre; oim[lane] = sim;
        }
        if (!has_next) break;
        u4 = u4n;
    }
}
__device__ __forceinline__ void ph_s5_carry(const Ctx& a, int i, int NGW) {
    int tid_ = threadIdx.x; asm volatile("" : "+v"(tid_)); const int lane = tid_ & 63, wave = __builtin_amdgcn_readfirstlane(tid_ >> 6), gw = blockIdx.x * NWAVES + wave; (void)wave;
    const f32x4* atab = (const f32x4*)(a.ws + WS_S5TAB + (size_t)i * S5TAB_STRIDE + S5T_A);
    float* car = (float*)(a.ws + WS_S5CAR);
    for (int u = gw; u < NB * S5G; u += NGW) {
        const int g = u & 63; const f32x4 av = atab[g * S5N + lane];
        float* cp = car + (size_t)u * 128 * 128;
        float cre = 0.f, cim = 0.f;
        float nr_[16], ni_[16];
#pragma unroll
        for (int k = 0; k < 16; ++k) { nr_[k] = cp[k * 128 + lane]; ni_[k] = cp[k * 128 + 64 + lane]; }
#pragma unroll 1
        for (int c0 = 0; c0 < 128; c0 += 16) {
            float er[16], ei[16];
#pragma unroll
            for (int k = 0; k < 16; ++k) { er[k] = nr_[k]; ei[k] = ni_[k]; }
            if (c0 + 16 < 128) {
#pragma unroll
                for (int k = 0; k < 16; ++k) { nr_[k] = cp[(c0 + 16 + k) * 128 + lane]; ni_[k] = cp[(c0 + 16 + k) * 128 + 64 + lane]; } }
#pragma unroll
            for (int k = 0; k < 16; ++k) {
                cp[(c0 + k) * 128 + lane] = cre; cp[(c0 + k) * 128 + 64 + lane] = cim;
                float nr = __builtin_fmaf(av.z, cre, er[k]); asm volatile("" : "+v"(nr));
                float ni = __builtin_fmaf(av.z, cim, ei[k]); asm volatile("" : "+v"(ni));
                nr = __builtin_fmaf(-av.w, cim, nr); asm volatile("" : "+v"(nr));
                ni = __builtin_fmaf(av.w, cre, ni); asm volatile("" : "+v"(ni));
                cre = nr; cim = ni;
            }
        }
    }
}

namespace att {
constexpr int KROWB = 384, KBYTES = 64 * KROWB, VBYTES = 16384, SLOT = KBYTES + VBYTES, NSLOT = 3, WS_OFF = NSLOT * SLOT;
static_assert(WS_OFF + NWAVES * 256 <= LDS_MAIN, "attention LDS");
constexpr float SCALE = 0.07216878364870322f, THR = 8.f;
#define ATT_KSWZ(row, colB) ((row) * att::KROWB + ((colB) ^ (((row) & 7) << 4)))
#define SBAR() __builtin_amdgcn_sched_barrier(0)
__device__ __forceinline__ int crow(int r, int hi) { return (r & 3) + 8 * (r >> 2) + 4 * hi; }

__device__ __forceinline__ void partialSM(f32x16& p0, f32x16& p1, float& m_reg, float& mn, float& alpha) {
    constexpr float C = SCALE * 1.4426950408889634f;
    float pmax = p0[0];
#pragma unroll
    for (int r = 1; r < 16; ++r) pmax = fmaxf(pmax, p0[r]);
#pragma unroll
    for (int r = 0; r < 16; ++r) pmax = fmaxf(pmax, p1[r]);
    { auto rr = __builtin_amdgcn_permlane32_swap(__float_as_uint(pmax), __float_as_uint(pmax), false, false); pmax = fmaxf(__uint_as_float(rr[0]), __uint_as_float(rr[1])); }
    if (__builtin_expect(__all(pmax - m_reg <= THR / SCALE), 1)) { mn = m_reg; alpha = 1.f; }
    else { mn = fmaxf(m_reg, pmax); alpha = __builtin_amdgcn_exp2f((m_reg - mn) * C); m_reg = mn; }
    const float mnC = -mn * C;
#pragma unroll
    for (int r = 0; r < 16; ++r) { p0[r] = __builtin_amdgcn_exp2f(fmaf(p0[r], C, mnC)); p1[r] = __builtin_amdgcn_exp2f(fmaf(p1[r], C, mnC)); }
}
__device__ __forceinline__ void finishSM(const f32x16& p0, const f32x16& p1, float alpha, float& l_reg, bf16x8& pa0, bf16x8& pa1, bf16x8& pa2, bf16x8& pa3) {
    float ps = 0.f;
#pragma unroll
    for (int r = 0; r < 16; ++r) ps += p0[r];
#pragma unroll
    for (int r = 0; r < 16; ++r) ps += p1[r];
    { auto rr = __builtin_amdgcn_permlane32_swap(__float_as_uint(ps), __float_as_uint(ps), false, false); ps = __uint_as_float(rr[0]) + __uint_as_float(rr[1]); }
    l_reg = l_reg * alpha + ps;
#define ATT_PK4(P, BASE, OUT) do { unsigned a0 = cvt_pk_bf16(P[BASE + 0], P[BASE + 1]), a1 = cvt_pk_bf16(P[BASE + 2], P[BASE + 3]);   \
    unsigned b0 = cvt_pk_bf16(P[BASE + 4], P[BASE + 5]), b1 = cvt_pk_bf16(P[BASE + 6], P[BASE + 7]);                              \
    auto r0 = __builtin_amdgcn_permlane32_swap(a0, b0, false, false); auto r1 = __builtin_amdgcn_permlane32_swap(a1, b1, false, false); \
    u32x4 w = {r0[0], r1[0], r0[1], r1[1]}; OUT = __builtin_bit_cast(bf16x8, w); } while (0)
    ATT_PK4(p0, 0, pa0); ATT_PK4(p0, 8, pa1); ATT_PK4(p1, 0, pa2); ATT_PK4(p1, 8, pa3);
#undef ATT_PK4
}
__device__ __forceinline__ int v_rd_base(int lane) { return ((lane & 3) << 3) | (((lane >> 2) & 3) << 6) | (((lane >> 4) & 1) << 5) | (((lane >> 5) & 1) << 8); }
constexpr int v_rd_off(int d0, int ks, int half) { return d0 * 512 + ks * 4096 + half * 2048; }
__device__ __forceinline__ void glds16(const void* gsrc, unsigned lds_dst) { unsigned keep;
    asm volatile("s_mov_b32 %0, m0\n\ts_mov_b32 m0, %2\n\ts_nop 0\n\tglobal_load_lds_dwordx4 %1, off\n\ts_mov_b32 m0, %0" : "=&s"(keep) : "v"(gsrc), "s"(lds_dst) : "memory"); }
template <int OFF> __device__ __forceinline__ s16x4 tr_read(int vb) { s16x4 r; asm volatile("ds_read_b64_tr_b16 %0, %1 offset:%2" : "=&v"(r) : "v"(vb), "i"(OFF) : "memory"); return r; }
template <int D0> __device__ __forceinline__ void pv_one(f32x16& od, int vb, bf16x8 pa0, bf16x8 pa1, bf16x8 pa2, bf16x8 pa3) {
    const s16x4 l0 = tr_read<v_rd_off(D0, 0, 0)>(vb), h0 = tr_read<v_rd_off(D0, 0, 1)>(vb), l1 = tr_read<v_rd_off(D0, 1, 0)>(vb), h1 = tr_read<v_rd_off(D0, 1, 1)>(vb);
    const s16x4 l2 = tr_read<v_rd_off(D0, 2, 0)>(vb), h2 = tr_read<v_rd_off(D0, 2, 1)>(vb), l3 = tr_read<v_rd_off(D0, 3, 0)>(vb), h3 = tr_read<v_rd_off(D0, 3, 1)>(vb);
    asm volatile("s_waitcnt lgkmcnt(0)" ::: "memory"); SBAR();
#define ATT_PK(L, H) (bf16x8){L[0], L[1], L[2], L[3], H[0], H[1], H[2], H[3]}
    od = __builtin_amdgcn_mfma_f32_32x32x16_bf16(pa0, ATT_PK(l0, h0), od, 0, 0, 0);
    od = __builtin_amdgcn_mfma_f32_32x32x16_bf16(pa1, ATT_PK(l1, h1), od, 0, 0, 0);
    od = __builtin_amdgcn_mfma_f32_32x32x16_bf16(pa2, ATT_PK(l2, h2), od, 0, 0, 0);
    od = __builtin_amdgcn_mfma_f32_32x32x16_bf16(pa3, ATT_PK(l3, h3), od, 0, 0, 0);
#undef ATT_PK
}

__device__ __forceinline__ void attn_phase(const Ctx& a, LAS unsigned char* lds, int vcu, int G) {
    int tid_ = threadIdx.x; asm volatile("" : "+v"(tid_));
    const int tid = tid_, lane = tid & 63, r32 = lane & 31, hi = lane >> 5; const int wid = __builtin_amdgcn_readfirstlane(tid >> 6);
    const bf16_t* Q = (const bf16_t*)(a.ws + WS_ACT + A_Q); const bf16_t* KV = (const bf16_t*)(a.ws + WS_ACT + A_KV); const bf16_t* AKR = (const bf16_t*)(a.ws + WS_ACT + A_AKR);
    bf16_t* OUT = (bf16_t*)(a.ws + WS_ACT + A_MIX);
    LAS float* wsf = (LAS float*)(lds + WS_OFF) + wid * 64; LAS float* li_l = wsf; LAS float* al_l = wsf + 32;
    const int ldsbase = (int)(unsigned)(size_t)lds;
    const int vbl = v_rd_base(lane);
    int krow[3], kcol[3], vkey[2], vcol[2];
#pragma unroll
    for (int ii = 0; ii < 3; ++ii) { const int s = (wid + 8 * ii) * 64 + lane, row = s / 24, chp = s - row * 24, ch = (chp & ~7) | ((chp ^ row) & 7); krow[ii] = row; kcol[ii] = 8 * ch; }
#pragma unroll
    for (int ii = 0; ii < 2; ++ii) { const int s = (wid + 8 * ii) * 64 + lane, kk = (s >> 7) * 8 + ((s & 31) >> 2); vcol[ii] = ((s >> 5) & 3) * 32 + 8 * (s & 3); vkey[ii] = (kk & ~0xC) | ((kk & 4) << 1) | ((kk & 8) >> 1); }

    for (int L = vcu; L < 1024 + DB * NH; L += G) {
        int qrow0, keyrow0, NT, h, ntw; bool active;
        if (L < 1024) { const int bh = (L & 255) >> 3, s = L & 7, k = L >> 8; const int qb = (k == 0) ? s : (k == 1) ? 15 - s : (k == 2) ? 16 + s : 31 - s;
            const int b = bh >> 3; h = bh & 7; qrow0 = b * SEQ + qb * 256; keyrow0 = b * SEQ; NT = 4 * (qb + 1); ntw = 4 * qb + (wid >> 1) + 1; active = true; }
        else { const int v = L - 1024, b = v >> 3; h = v & 7; qrow0 = MP + b * DS; keyrow0 = MP + b * KEYS_S; NT = KEYS_S / 64; active = wid < 2; ntw = active ? NT : 0; }
        const char* ksrc[3]; int kstride[3]; const char* vsrc[2];
#pragma unroll
        for (int ii = 0; ii < 3; ++ii) {
            if (kcol[ii] < 128) { ksrc[ii] = (const char*)(KV + (size_t)(keyrow0 + krow[ii]) * KVW + h * 256 + kcol[ii]); kstride[ii] = 64 * KVW * 2; }
            else { ksrc[ii] = (const char*)(AKR + (size_t)(keyrow0 + krow[ii]) * ROPE + (kcol[ii] - 128)); kstride[ii] = 64 * ROPE * 2; }
        }
#pragma unroll
        for (int ii = 0; ii < 2; ++ii) vsrc[ii] = (const char*)(KV + (size_t)(keyrow0 + vkey[ii]) * KVW + h * 256 + 128 + vcol[ii]);
#define ATT_DMA(t, sl) do { \
        _Pragma("unroll") for (int ii = 0; ii < 3; ++ii) glds16(ksrc[ii] + (size_t)(t) * kstride[ii], (unsigned)__builtin_amdgcn_readfirstlane(ldsbase + (sl) * SLOT + (wid + 8 * ii) * 1024)); \
        _Pragma("unroll") for (int ii = 0; ii < 2; ++ii) glds16(vsrc[ii] + (size_t)(t) * (64 * KVW * 2), (unsigned)__builtin_amdgcn_readfirstlane(ldsbase + (sl) * SLOT + KBYTES + (wid + 8 * ii) * 1024)); } while (0)
        bf16x8 qr[12];
        if (active) { const bf16_t* Qw = Q + (size_t)(qrow0 + wid * 32 + r32) * QW + h * QHD + hi * 8;
#pragma unroll
            for (int d0 = 0; d0 < 12; ++d0) qr[d0] = *(const bf16x8*)(Qw + d0 * 16); }
        else {
#pragma unroll
            for (int d0 = 0; d0 < 12; ++d0) qr[d0] = (bf16x8){0, 0, 0, 0, 0, 0, 0, 0}; }
#pragma unroll
        for (int d0 = 0; d0 < 12; ++d0) asm volatile("" : "+v"(qr[d0]));
        ATT_DMA(0, 0);
        if (NT > 1) ATT_DMA(1, 1);
        float m_reg = -1e30f, l_reg = 0.f; f32x16 o[4];
#pragma unroll
        for (int d = 0; d < 4; ++d) o[d] = (f32x16){};
        int sl = 0;
        for (int t = 0; t < NT; ++t) {
            if (t + 1 < NT) asm volatile("s_waitcnt vmcnt(5)" ::: "memory"); else asm volatile("s_waitcnt vmcnt(0)" ::: "memory");
            __builtin_amdgcn_s_barrier(); asm volatile("" ::: "memory");
            if (t + 2 < NT) { const int sl2 = (sl >= 1) ? sl - 1 : 2; ATT_DMA(t + 2, sl2); }
            if (t < ntw) {
                const LAS char* Ks = (const LAS char*)(lds + sl * SLOT);
                f32x16 p0 = {}, p1 = {};
                int ka[4];
#pragma unroll
                for (int j = 0; j < 4; ++j) ka[j] = ldsbase + sl * SLOT + r32 * KROWB + ((j * 32 + hi * 16) ^ ((r32 & 7) << 4));
                bf16x8 kb[3][2];
#define ATT_KRD(d) do { asm volatile("ds_read_b128 %0, %1 offset:%2" : "=v"(kb[(d) % 3][0]) : "v"(ka[(d) & 3]), "i"(((d) >> 2) * 128) : "memory"); \
                        asm volatile("ds_read_b128 %0, %1 offset:%2" : "=v"(kb[(d) % 3][1]) : "v"(ka[(d) & 3]), "i"(((d) >> 2) * 128 + 32 * KROWB) : "memory"); } while (0)
                ATT_KRD(0); ATT_KRD(1);
#pragma unroll
                for (int d0 = 0; d0 < 12; ++d0) {
                    if (d0 + 2 < 12) { ATT_KRD(d0 + 2); asm volatile("s_waitcnt lgkmcnt(4)" ::: "memory"); }
                    else if (d0 + 1 < 12) asm volatile("s_waitcnt lgkmcnt(2)" ::: "memory");
                    else asm volatile("s_waitcnt lgkmcnt(0)" ::: "memory");
                    SBAR();
                    p0 = __builtin_amdgcn_mfma_f32_32x32x16_bf16(kb[d0 % 3][0], qr[d0], p0, 0, 0, 0);
                    p1 = __builtin_amdgcn_mfma_f32_32x32x16_bf16(kb[d0 % 3][1], qr[d0], p1, 0, 0, 0);
                    SBAR(); }
#undef ATT_KRD
                float mn, alpha; bf16x8 pa0, pa1, pa2, pa3;
                partialSM(p0, p1, m_reg, mn, alpha);
                finishSM(p0, p1, alpha, l_reg, pa0, pa1, pa2, pa3);
                if (__any(alpha < 1.f)) { if (hi == 0) al_l[r32] = alpha; asm volatile("s_waitcnt lgkmcnt(0)" ::: "memory");
#pragma unroll
                    for (int d = 0; d < 4; ++d)
#pragma unroll
                        for (int r = 0; r < 16; ++r) o[d][r] *= al_l[crow(r, hi)]; }
                const int vb = ldsbase + sl * SLOT + KBYTES + vbl;
                pv_one<0>(o[0], vb, pa0, pa1, pa2, pa3); pv_one<1>(o[1], vb, pa0, pa1, pa2, pa3); pv_one<2>(o[2], vb, pa0, pa1, pa2, pa3); pv_one<3>(o[3], vb, pa0, pa1, pa2, pa3);
            }
            sl = (sl == 2) ? 0 : sl + 1;
        }
        if (active) {

            if (hi == 0) li_l[r32] = l_reg; asm volatile("s_waitcnt lgkmcnt(0)" ::: "memory");
            int hi_o = hi, r32_o = r32; asm volatile("" : "+v"(hi_o), "+v"(r32_o));
            bf16_t* Ow = OUT + (size_t)(qrow0 + wid * 32) * DM + h * 128 + r32_o;
#pragma unroll
            for (int r = 0; r < 16; ++r) { const int orow = crow(r, hi_o); const float rl = __builtin_amdgcn_rcpf(li_l[orow]);
#pragma unroll
                for (int d0 = 0; d0 < 4; ++d0) Ow[(size_t)orow * DM + d0 * 32] = f2bf(o[d0][r] * rl); }
        }
        asm volatile("s_waitcnt lgkmcnt(0)" ::: "memory"); __builtin_amdgcn_s_barrier(); asm volatile("" ::: "memory");
#undef ATT_DMA
    }
}
#undef SBAR
}

namespace ret {
constexpr int QP = 528, VP = 144, PP = 144, XP = 68;
constexpr int OFF_Q = 0, OFF_K = 64 * QP, OFF_V = 2 * 64 * QP, OFF_P = OFF_V + 64 * VP, OFF_X = OFF_P + 64 * PP, END = OFF_X + 64 * XP * 4;
static_assert(END <= LDS_MAIN, "retention LDS");
typedef short v4i16 __attribute__((ext_vector_type(4)));
__device__ __forceinline__ s16x4 trd(const LAS unsigned char* p) { return __builtin_bit_cast(s16x4, __builtin_amdgcn_ds_read_tr16_b64_v4i16((LAS v4i16*)p)); }
#define RET_SB() __builtin_amdgcn_sched_barrier(0)
#define RET_BAR() do { asm volatile("s_waitcnt lgkmcnt(0)" ::: "memory"); __builtin_amdgcn_s_barrier(); asm volatile("" ::: "memory"); } while (0)

__device__ __forceinline__ void ret_phase(const Ctx& a, int i, LAS unsigned char* lds, int vcu, int G, bool store_o) {
    int tid_ = threadIdx.x; asm volatile("" : "+v"(tid_));
    const int tid = tid_, lane = tid & 63, l15 = lane & 15, kg = lane >> 4, tq = (lane & 15) >> 2, tp = lane & 3; const int wid = __builtin_amdgcn_readfirstlane(tid >> 6);
    const int dh = wid >> 2, dq = wid & 3;
    bf16_t* X = (bf16_t*)(a.ws + WS_ACT + A_INC);
    LAS unsigned char* QS = lds + OFF_Q; LAS unsigned char* KS = lds + OFF_K; LAS unsigned char* VS = lds + OFF_V; LAS unsigned char* PS = lds + OFF_P; LAS float* XS = (LAS float*)(lds + OFF_X);
    constexpr int NU_P = NB * RH * 8, NU_S = DB * RH * 8;
    for (int L = vcu; L < NU_P + NU_S; L += G) {
        int b, h, dvb, row0, nch; bool samp;
        if (L < NU_P) { samp = false; dvb = L & 7; h = (L >> 3) & 7; b = L >> 6; row0 = b * SEQ; nch = SEQ / 64; }
        else { const int v = L - NU_P; samp = true; dvb = v & 7; h = (v >> 3) & 7; b = v >> 6; row0 = MP + b * DS; nch = 1; }
        const float e1 = __builtin_amdgcn_exp2f(-5.0f - (float)h);
        const float log2g = -1.4426950408889634f * (e1 * (1.0f + e1 * (0.5f + e1 * (0.33333333f + e1 * (0.25f + e1 * (0.2f + e1 * (0.16666667f + e1 * 0.14285714f)))))));
        const float g64 = __builtin_amdgcn_exp2f(64.f * log2g);
        f32x4 S[8];
        if (samp) { const GAS float* sp = (const GAS float*)arg_in(6) + ((((size_t)i * DB + b) * RH + h) * RDK) * RDV + dvb * 64 + 16 * dq + l15 + (size_t)(64 * dh + 2 * kg) * RDV;
#pragma unroll
            for (int j = 0; j < 8; ++j) {
#pragma unroll
                for (int r = 0; r < 4; ++r) S[j][r] = sp[((r >> 1) + 128 * (r & 1)) * RDV];
                sp += 8 * RDV; asm volatile("" : "+v"(sp)); } }
        else {
#pragma unroll
            for (int j = 0; j < 8; ++j) S[j] = (f32x4){0.f, 0.f, 0.f, 0.f}; }
        const int srow = tid >> 5, scc = tid & 31, vrow = tid >> 3, vcc = tid & 7;
        const bf16_t* gq = X + (size_t)(row0 + srow) * INC + C_RQ + h * RDK + 8 * scc;
        const bf16_t* gv = X + (size_t)(row0 + vrow) * INC + C_RV + h * RDV + dvb * 64 + 8 * vcc;
        float kf[4], pf[4], of[2][4];
#pragma unroll
        for (int k = 0; k < 4; ++k) kf[k] = __builtin_amdgcn_exp2f((float)(63 - (srow + 16 * k)) * log2g);
#pragma unroll
        for (int r = 0; r < 4; ++r) pf[r] = __builtin_amdgcn_exp2f((float)(16 * (wid >> 1) + 4 * kg + r - 63) * log2g);
#pragma unroll
        for (int e = 0; e < 2; ++e)
#pragma unroll
            for (int r = 0; r < 4; ++r) of[e][r] = __builtin_amdgcn_exp2f((float)(16 * (2 * dh + e) + 4 * kg + r + 1) * log2g);
        u32x4 pq[4], pk[4], pv;
#pragma unroll
        for (int k = 0; k < 4; ++k) { pq[k] = *(const u32x4*)(gq + (size_t)(16 * k) * INC); pk[k] = *(const u32x4*)(gq + (size_t)(16 * k) * INC + C_RK); }
        pv = *(const u32x4*)gv;
#pragma unroll 1
        for (int c = 0; c < nch; ++c) {
#pragma unroll
            for (int k = 0; k < 4; ++k) {
                const int m = srow + 16 * k;
                *(LAS u32x4*)(QS + m * QP + scc * 16) = pq[k];
                const float f = kf[k];
                u32x4 w = pk[k];
                w.x = cvt_pk_bf16(bf_lo(w.x) * f, bf_hi(w.x) * f); w.y = cvt_pk_bf16(bf_lo(w.y) * f, bf_hi(w.y) * f); w.z = cvt_pk_bf16(bf_lo(w.z) * f, bf_hi(w.z) * f); w.w = cvt_pk_bf16(bf_lo(w.w) * f, bf_hi(w.w) * f);
                *(LAS u32x4*)(KS + m * QP + scc * 16) = w;
            }
            *(LAS u32x4*)(VS + vrow * VP + vcc * 16) = pv;
            RET_BAR();
            if (c + 1 < nch) {
                const size_t adv = (size_t)(c + 1) * 64 * INC;
#pragma unroll
                for (int k = 0; k < 4; ++k) { pq[k] = *(const u32x4*)(gq + adv + (size_t)(16 * k) * INC); pk[k] = *(const u32x4*)(gq + adv + (size_t)(16 * k) * INC + C_RK); }
                pv = *(const u32x4*)(gv + adv);
            }
            {
                const int nt = wid >> 1, mt0 = 2 * (wid & 1);
                f32x4 sc[2] = {(f32x4){0.f, 0.f, 0.f, 0.f}, (f32x4){0.f, 0.f, 0.f, 0.f}};
                bf16x8 fa[4][2], fb[4][2][2];
#define RET_LD1(gq) do { _Pragma("unroll") for (int k2 = 0; k2 < 2; ++k2) { const int ks = 2 * (gq) + k2; fa[gq][k2] = *(const LAS bf16x8*)(QS + (16 * nt + l15) * QP + (32 * ks + 8 * kg) * 2); \
                        _Pragma("unroll") for (int e = 0; e < 2; ++e) fb[gq][k2][e] = *(const LAS bf16x8*)(KS + (16 * (mt0 + e) + l15) * QP + (32 * ks + 8 * kg) * 2); } } while (0)
#define RET_MM1(gq) do { _Pragma("unroll") for (int k2 = 0; k2 < 2; ++k2) _Pragma("unroll") for (int e = 0; e < 2; ++e) sc[e] = __builtin_amdgcn_mfma_f32_16x16x32_bf16(fa[gq][k2], fb[gq][k2][e], sc[e], 0, 0, 0); } while (0)
                if (mt0 + 1 <= nt) {
                    RET_LD1(0); RET_LD1(1); RET_SB();
                    RET_MM1(0); RET_LD1(2); RET_SB();
                    RET_MM1(1); RET_LD1(3); RET_SB();
                    RET_MM1(2); RET_SB();
                    RET_MM1(3);
                } else if (mt0 <= nt) {
#define RET_LD1H(gq) do { _Pragma("unroll") for (int k2 = 0; k2 < 2; ++k2) { const int ks = 2 * (gq) + k2; fa[gq][k2] = *(const LAS bf16x8*)(QS + (16 * nt + l15) * QP + (32 * ks + 8 * kg) * 2); \
                        fb[gq][k2][0] = *(const LAS bf16x8*)(KS + (16 * mt0 + l15) * QP + (32 * ks + 8 * kg) * 2); } } while (0)
#define RET_MM1H(gq) do { _Pragma("unroll") for (int k2 = 0; k2 < 2; ++k2) sc[0] = __builtin_amdgcn_mfma_f32_16x16x32_bf16(fa[gq][k2], fb[gq][k2][0], sc[0], 0, 0, 0); } while (0)
                    RET_LD1H(0); RET_LD1H(1); RET_LD1H(2); RET_LD1H(3); RET_SB();
                    RET_MM1H(0); RET_MM1H(1); RET_MM1H(2); RET_MM1H(3);
#undef RET_LD1H
#undef RET_MM1H
                }
#undef RET_LD1
#undef RET_MM1
#pragma unroll
                for (int e = 0; e < 2; ++e)
#pragma unroll
                    for (int r = 0; r < 4; ++r) { const int n = 16 * nt + 4 * kg + r, m = 16 * (mt0 + e) + l15;
                        const float pvv = (m <= n) ? sc[e][r] * pf[r] : 0.f;
                        *(LAS bf16_t*)(PS + n * PP + m * 2) = f2bf(pvv); }
            }
            RET_BAR();
            bf16x8 vb[2];
#pragma unroll
            for (int ks = 0; ks < 2; ++ks) { const LAS unsigned char* p = VS + (32 * ks + 8 * kg + tq) * VP + (16 * dq + 4 * tp) * 2;
                const s16x4 lo = trd(p), hi4 = trd(p + 4 * VP); vb[ks] = (bf16x8){lo[0], lo[1], lo[2], lo[3], hi4[0], hi4[1], hi4[2], hi4[3]}; }
            f32x4 inn[2] = {(f32x4){0.f, 0.f, 0.f, 0.f}, (f32x4){0.f, 0.f, 0.f, 0.f}};
            f32x4 cx[4] = {(f32x4){0.f, 0.f, 0.f, 0.f}, (f32x4){0.f, 0.f, 0.f, 0.f}, (f32x4){0.f, 0.f, 0.f, 0.f}, (f32x4){0.f, 0.f, 0.f, 0.f}};
            {
                bf16x8 pa_[2][2]; u32x2 qa[4][4][2];
#define RET_LD2(s_) do { _Pragma("unroll") for (int nt = 0; nt < 4; ++nt) { const LAS unsigned char* p = QS + (16 * nt + l15) * QP + (128 * dh + 32 * (s_) + 4 * kg) * 2; \
                        qa[s_][nt][0] = *(const LAS u32x2*)p; qa[s_][nt][1] = *(const LAS u32x2*)(p + 32); } } while (0)
#define RET_MM2(s_) do { const u32x4 bw = {cvt_pk_bf16(S[2 * (s_)][0], S[2 * (s_)][1]), cvt_pk_bf16(S[2 * (s_)][2], S[2 * (s_)][3]), cvt_pk_bf16(S[2 * (s_) + 1][0], S[2 * (s_) + 1][1]), cvt_pk_bf16(S[2 * (s_) + 1][2], S[2 * (s_) + 1][3])}; \
                        const bf16x8 B = __builtin_bit_cast(bf16x8, bw); \
                        _Pragma("unroll") for (int nt = 0; nt < 4; ++nt) { const u32x4 aw = {qa[s_][nt][0].x, qa[s_][nt][0].y, qa[s_][nt][1].x, qa[s_][nt][1].y}; \
                            cx[nt] = __builtin_amdgcn_mfma_f32_16x16x32_bf16(__builtin_bit_cast(bf16x8, aw), B, cx[nt], 0, 0, 0); } } while (0)
#pragma unroll
                for (int e = 0; e < 2; ++e)
#pragma unroll
                    for (int ks = 0; ks < 2; ++ks) if (ks == 0 || dh == 1) pa_[e][ks] = *(const LAS bf16x8*)(PS + (16 * (2 * dh + e) + l15) * PP + (32 * ks + 8 * kg) * 2);
                RET_LD2(0); RET_LD2(1); RET_SB();
#pragma unroll
                for (int e = 0; e < 2; ++e)
#pragma unroll
                    for (int ks = 0; ks < 2; ++ks) if (ks == 0 || dh == 1) inn[e] = __builtin_amdgcn_mfma_f32_16x16x32_bf16(pa_[e][ks], vb[ks], inn[e], 0, 0, 0);
                RET_LD2(2); RET_SB();
                RET_MM2(0); RET_LD2(3); RET_SB();
                RET_MM2(1); RET_SB();
                RET_MM2(2); RET_SB();
                RET_MM2(3);
#undef RET_LD2
#undef RET_MM2
            }
            { const f32x4 g0 = dh ? cx[0] : cx[2], g1 = dh ? cx[1] : cx[3]; const int ntb = dh ? 0 : 2;
#pragma unroll
                for (int r = 0; r < 4; ++r) { XS[(16 * ntb + 4 * kg + r) * XP + 16 * dq + l15] = g0[r]; XS[(16 * (ntb + 1) + 4 * kg + r) * XP + 16 * dq + l15] = g1[r]; } }
            RET_BAR();
            { const f32x4 m0 = dh ? cx[2] : cx[0], m1 = dh ? cx[3] : cx[1];
                bf16_t* go = X + (size_t)(row0 + c * 64) * INC + C_RV + h * RDV + dvb * 64 + 16 * dq + l15;
#pragma unroll
                for (int e = 0; e < 2; ++e)
#pragma unroll
                    for (int r = 0; r < 4; ++r) { const int n = 16 * (2 * dh + e) + 4 * kg + r;
                        const float other = XS[n * XP + 16 * dq + l15]; const float mine = e ? m1[r] : m0[r];
                        const float ov = inn[e][r] + of[e][r] * (mine + other);
                        if (store_o) go[(size_t)n * INC] = f2bf(ov); } }
#pragma unroll
            for (int j = 0; j < 8; ++j) S[j] = S[j] * g64;
            {
                s16x4 kt[2][8][2];
#define RET_LD3(ks) do { _Pragma("unroll") for (int j = 0; j < 8; ++j) { const LAS unsigned char* p = KS + (32 * (ks) + 8 * kg + tq) * QP + (128 * dh + 16 * j + 4 * tp) * 2; kt[ks][j][0] = trd(p); kt[ks][j][1] = trd(p + 4 * QP); } } while (0)
#define RET_MM3(ks) do { _Pragma("unroll") for (int j = 0; j < 8; ++j) { const s16x4 lo = kt[ks][j][0], hi4 = kt[ks][j][1]; const bf16x8 A = (bf16x8){lo[0], lo[1], lo[2], lo[3], hi4[0], hi4[1], hi4[2], hi4[3]}; \
                        S[j] = __builtin_amdgcn_mfma_f32_16x16x32_bf16(A, vb[ks], S[j], 0, 0, 0); } } while (0)
                RET_LD3(0); RET_SB(); RET_LD3(1); RET_SB();
                RET_MM3(0); RET_SB();
                RET_MM3(1);
#undef RET_LD3
#undef RET_MM3
            }
            RET_BAR();
        }
        { GAS float* so = (GAS float*)(samp ? a.out + O_RET_S + ((((size_t)i * DB + b) * RH + h) * RDK) * RDV : a.out + O_RET_P + ((((size_t)i * NB + b) * RH + h) * RDK) * RDV) + dvb * 64 + 16 * dq + l15 + (size_t)(64 * dh + 2 * kg) * RDV;
#pragma unroll
            for (int j = 0; j < 8; ++j) {
#pragma unroll
                for (int r = 0; r < 4; ++r) so[((r >> 1) + 128 * (r & 1)) * RDV] = S[j][r];
                so += 8 * RDV; asm volatile("" : "+v"(so)); } }
    }
}
#undef RET_BAR
#undef RET_SB
}

#ifndef MK_PER_PHASE
#define MK_PER_PHASE 0
#endif
constexpr int PPL = 10, PH_FINAL = 1 + PPL * DEPTH, NPH = PH_FINAL + 1;

__global__ void __launch_bounds__(NTHREADS, 2) fwd_kernel(Args args) {
    extern __shared__ __attribute__((aligned(16))) unsigned char lds_raw[];
    LAS unsigned char* lds = (LAS unsigned char*)lds_raw;
        const int G = gridDim.x, bid = blockIdx.x;
    const int vcu = (G % 8 == 0) ? (bid % 8) * (G / 8) + bid / 8 : bid;
    const int NGW = G * NWAVES;
    const int lo = args.ph_lo, hi = args.ph_hi;
    if (threadIdx.x < 4) ((LAS unsigned*)(lds + LDSCTL_OFF))[threadIdx.x] = 0u;
    __syncthreads();
    XcdBarrier bar; bar.bar = (unsigned*)(args.ws + WS_CTL) + CW_BAR; bar.x = 0; bar.st = nullptr;
    if (!MK_PER_PHASE) bar = xcd_barrier_post((unsigned*)(args.ws + WS_CTL) + CW_BAR, (volatile LAS unsigned*)(lds + LDSCTL_OFF));
#define IN(k) (lo <= (k) && (k) < hi)
#define SEAM(k) do { if (!MK_PER_PHASE && (k) + 1 < hi) { XcdBarrier b2_ = bar; b2_.bar = opaque(bar.bar); { unsigned x_ = bar.x; asm volatile("" : "+s"(x_)); b2_.x = x_; } xcd_barrier(b2_); } } while (0)


    if (IN(0)) { Ctx al; al.ws = as_global(args.ws); al.out = as_global(args.out); ph_tables(al, G * NTHREADS); SEAM(0); }


#pragma unroll 1
    for (int L = 0; L < DEPTH; ++L) {
        const int base = 1 + PPL * L, i = L >> 1;
        Ctx al; al.ws = opaque(args.ws); al.out = opaque(args.out);
        unsigned char* const ws = al.ws;
        float* const X = al.out + O_Y;
        bf16_t* const H = (bf16_t*)(ws + WS_ACT + A_H);
        unsigned char* const wb = ws + WS_W + (size_t)(L & 1) * W_BUF;
        float* const rssA = (float*)(ws + WS_RSS); float* const rssB = (float*)(ws + WS_RSS + RSS_BANK); float* const rssP = (float*)(ws + WS_RSSP);
        const float* xp = (L == 0) ? arg_in(0) : X;
        const float* xs = (L == 0) ? arg_in(1) - (size_t)MP * DM : X;
        if (IN(base + 0)) {
            ph_convert(al, L, lds, 0, 1 << 30, 0, G);
            if (L == 0) { const f32x4* src = (const f32x4*)arg_in(1); f32x4* dst = (f32x4*)(X + (size_t)MP * DM);
                int t0 = threadIdx.x; asm volatile("" : "+v"(t0));
                for (int e = bid * NTHREADS + t0; e < MS * DM / 4; e += G * NTHREADS) dst[e] = src[e]; }
            if (L == 0) ph_xprep(xp, xs, H, rssA, 0, M, NGW, nullptr, 0, nullptr, nullptr);
            else { ph_xprep(X, X, H, rssA, MP, MP, NGW, nullptr, 0, nullptr, rssP); ph_xprep_samp(X, H, rssA, (const float*)(ws + WS_ACT + A_PART), FF / 512, (LAS float*)lds); }
            SEAM(base + 0);
        }
        if ((L & 1) == 0) {
            if (IN(base + 1)) {
                pg8::Gemm g{H, (const bf16_t*)(wb + W_INAB), M, INABP, DM, DM, DM, 0}; pg8::StaticOrder S; S.init(M, INABP, G, bid);
                pg8::EpiBf16<0> E{nullptr, 0, false, (bf16_t*)(ws + WS_ACT + A_INAB), INABP, rssA};
                pg8::gemm_phase<pg8::EpiBf16<0>, pg8::StaticOrder, true, true>(lds, g, S, E);
                SEAM(base + 1);
            }
            if (IN(base + 2)) {
                ph_mla_post(al, i, NGW);

                ph_s5<0>(al, i, lds, NGW);

                SEAM(base + 2);
            }
            if (IN(base + 3)) {
                ph_s5_carry(al, i, NGW);
                { pg8::Gemm g{(const bf16_t*)(ws + WS_ACT + A_CQN), (const bf16_t*)(wb + W_QB), M, QW, QL, QL, QL, 0}; pg8::StaticOrder S; S.init(M, QW, G, (bid + (G / 4)) % G);
                  pg8::EpiBf16<0> E{(const f32x2*)(ws + WS_ROPE), 2, false, (bf16_t*)(ws + WS_ACT + A_Q), QW, nullptr};
                  pg8::gemm_phase<pg8::EpiBf16<0>, pg8::StaticOrder, true, true>(lds, g, S, E); }
                { pg8::Gemm g{(const bf16_t*)(ws + WS_ACT + A_ACKV), (const bf16_t*)(wb + W_KVB), KROWS, KVW, KVL, KVL, KVL, 0}; pg8::StaticOrder S; S.init(KROWS, KVW, G, (bid + (G / 16) * 8) % G);
                  pg8::EpiBf16<0> E{nullptr, 0, false, (bf16_t*)(ws + WS_ACT + A_KV), KVW, nullptr};
                  pg8::gemm_phase<pg8::EpiBf16<0>, pg8::StaticOrder, true, true>(lds, g, S, E); }
                SEAM(base + 3);
            }
            if (IN(base + 4)) {

                ph_s5<1>(al, i, lds, NGW);

                SEAM(base + 4);
            }
            if (IN(base + 5)) {

                att::attn_phase(al, lds, vcu, G);

                { pg8::Gemm g{(const bf16_t*)(ws + WS_ACT + A_Z), (const bf16_t*)(wb + W_GLU), M, S5W, S5W, S5W, S5W, 0}; pg8::StaticOrder S; S.init(M, S5W, G, bid); if (G == 256) { S.skip = DB * NH; S.vc = vcu; }
                  pg8::EpiGlu E{(bf16_t*)(ws + WS_ACT + A_MIX), DM, S5W, (const bf16_t*)(ws + WS_ACT + A_Z), S5W, arg_in(24) + i * S5W};
                  pg8::gemm_phase<pg8::EpiGlu, pg8::StaticOrder, true, true>(lds, g, S, E); }
                SEAM(base + 5);
            }
            if (IN(base + 6)) {
                { pg8::Gemm g{(const bf16_t*)(ws + WS_ACT + A_MIX), (const bf16_t*)(wb + W_OUTAB), MP, DM, DM, DM, DM, 0}; pg8::StaticOrder S; S.init(MP, DM, G, bid, 4);
                  pg8::EpiRes E{xp, (L == 0) ? (const bf16_t*)nullptr : (const bf16_t*)H, DM, H, rssP};
                  pg8::gemm_phase<pg8::EpiRes, pg8::StaticOrder, true, true>(lds, g, S, E); }
                { pg8::Gemm g{(const bf16_t*)(ws + WS_ACT + A_MIX) + (size_t)MP * DM, (const bf16_t*)(wb + W_OUTAB), MS, DM, 256, DM, DM, 256}; pg8::SplitOrder S; S.init(MS, DM, DM / 256, G, bid);
                  pg8::EpiSlab E{(float*)(ws + WS_ACT + A_PART), DM, MS};
                  pg8::gemm_phase<pg8::EpiSlab, pg8::SplitOrder, true, true>(lds, g, S, E); }
                SEAM(base + 6);
            }
        } else {
            if (IN(base + 1)) {
                pg8::Gemm g{H, (const bf16_t*)(wb + W_INC), M, INC, DM, DM, DM, 0}; pg8::StaticOrder S; S.init(M, INC, G, bid);
                pg8::EpiBf16<0> E{(const f32x2*)(ws + WS_ROPE), 1, false, (bf16_t*)(ws + WS_ACT + A_INC), INC, rssA};
                pg8::gemm_phase<pg8::EpiBf16<0>, pg8::StaticOrder, true, true>(lds, g, S, E);
                SEAM(base + 2);
            }

            if (IN(base + 3)) {
                ret::ret_phase(al, i, lds, vcu, G, true); SEAM(base + 3); }

            if (IN(base + 4)) {
                ph_gn_gate(al, i, NGW); SEAM(base + 5); }
            if (IN(base + 6)) {
                { pg8::Gemm g{(const bf16_t*)(ws + WS_ACT + A_INC) + C_RV, (const bf16_t*)(wb + W_OUTC), MP, DM, RH * RDV, INC, RH * RDV, 0}; pg8::StaticOrder S; S.init(MP, DM, G, bid, 4);
                  pg8::EpiRes E{nullptr, H, DM, H, rssP};
                  pg8::gemm_phase<pg8::EpiRes, pg8::StaticOrder, true, true>(lds, g, S, E); }
                { pg8::Gemm g{(const bf16_t*)(ws + WS_ACT + A_INC) + C_RV + (size_t)MP * INC, (const bf16_t*)(wb + W_OUTC), MS, DM, 512, INC, RH * RDV, 512}; pg8::SplitOrder S; S.init(MS, DM, (RH * RDV) / 512, G, bid);
                  pg8::EpiSlab E{(float*)(wb + W_INC), DM, MS};
                  pg8::gemm_phase<pg8::EpiSlab, pg8::SplitOrder, true, true>(lds, g, S, E); }
                SEAM(base + 6);
            }
        }
        if (IN(base + 7)) {
            ph_xprep(X, X, H, rssB, MP, MP, NGW, nullptr, 0, nullptr, rssP); ph_xprep_samp(X, H, rssB, ((L & 1) == 0) ? (const float*)(ws + WS_ACT + A_PART) : (const float*)(wb + W_INC), 8, (LAS float*)lds);
            SEAM(base + 7); }
        if (IN(base + 8)) {
            pg8::Gemm g{H, (const bf16_t*)(wb + W_UP), M, FF, DM, DM, DM, 0}; pg8::StaticOrder S; S.init(M, FF, G, bid);
            pg8::EpiBf16<1> E{nullptr, 0, false, (bf16_t*)(ws + WS_ACT + A_FF), FF, rssB};
            pg8::gemm_phase<pg8::EpiBf16<1>, pg8::StaticOrder, true, true>(lds, g, S, E);
            SEAM(base + 8);
        }
        if (IN(base + 9)) {
            { pg8::Gemm g{(const bf16_t*)(ws + WS_ACT + A_FF), (const bf16_t*)(wb + W_DOWN), MP, DM, FF, FF, FF, 0}; pg8::StaticOrder S; S.init(MP, DM, G, bid, 4);
              pg8::EpiRes E{nullptr, H, DM, H, rssP};
              pg8::gemm_phase<pg8::EpiRes, pg8::StaticOrder, true, true>(lds, g, S, E); }
            { pg8::Gemm g{(const bf16_t*)(ws + WS_ACT + A_FF) + (size_t)MP * FF, (const bf16_t*)(wb + W_DOWN), MS, DM, 512, FF, FF, 512}; pg8::SplitOrder S; S.init(MS, DM, FF / 512, G, bid);
              pg8::EpiSlab E{(float*)(ws + WS_ACT + A_PART), DM, MS};
              pg8::gemm_phase<pg8::EpiSlab, pg8::SplitOrder, true, true>(lds, g, S, E); }
            SEAM(base + 9);
        }
    }
    if (IN(PH_FINAL)) { float* const X = as_global(args.out) + O_Y;
        ph_rmsnorm<true>(X, X, arg_in(9), nullptr, X, NGW, (const float*)(as_global(args.ws) + WS_ACT + A_PART), FF / 512, X, (const bf16_t*)(as_global(args.ws) + WS_ACT + A_H));

    }
#undef IN
#undef SEAM
}

extern "C" void kernel_launch(void* const* d_in, const int* in_sizes, int n_in, void* d_out, int out_size, void* d_ws, size_t ws_size, hipStream_t stream) {
    static int grid = 0;
    if (grid == 0) {
        if (n_in != 31 || out_size != (int)O_END || ws_size < WS_END) { fprintf(stderr, "kernel_launch: unexpected shapes: n_in %d out %d ws %zu (need %zu)\n", n_in, out_size, ws_size, (size_t)WS_END); grid = -1; return; }
        int dev = 0, cus = 0, per_cu = 0;
        if (hipGetDevice(&dev) != hipSuccess || hipDeviceGetAttribute(&cus, hipDeviceAttributeMultiprocessorCount, dev) != hipSuccess) { grid = -1; return; }
        if (hipFuncSetAttribute((const void*)fwd_kernel, hipFuncAttributeMaxDynamicSharedMemorySize, LDS_BYTES) != hipSuccess) { fprintf(stderr, "kernel_launch: hipFuncSetAttribute failed\n"); grid = -1; return; }
        if (hipOccupancyMaxActiveBlocksPerMultiprocessor(&per_cu, (const void*)fwd_kernel, NTHREADS, LDS_BYTES) != hipSuccess || per_cu < 1) { fprintf(stderr, "kernel_launch: occupancy query says %d blocks/CU\n", per_cu); (void)hipGetLastError(); grid = -1; return; }
        grid = cus;
    }
    if (grid < 0) return;
    if (hipMemsetAsync((char*)d_ws + WS_CTL, 0, CTL_ZERO_BYTES, stream) != hipSuccess) return;
    Args a{};
    for (int k = 0; k < 31; ++k) a.in[k] = (const float*)d_in[k];
    a.out = (float*)d_out; a.ws = (unsigned char*)d_ws;
#if MK_PER_PHASE
    for (int p = 0; p < NPH; ++p) {
        if (p >= 1 && p < PH_FINAL) { const int L = (p - 1) / PPL, k = (p - 1) % PPL; if ((L & 1) && (k == 5 || k == 2)) continue; }
        a.ph_lo = p; a.ph_hi = p + 1;
        hipLaunchKernelGGL(fwd_kernel, dim3(grid), dim3(NTHREADS), LDS_BYTES, stream, a);
    }
#else
    a.ph_lo = 0; a.ph_hi = NPH;
    hipLaunchKernelGGL(fwd_kernel, dim3(grid), dim3(NTHREADS), LDS_BYTES, stream, a);
#endif
    const hipError_t le = hipPeekAtLastError();
    if (le != hipSuccess) fprintf(stderr, "kernel_launch: launch failed: %s\n", hipGetErrorName(le));
}
```

```cpp
#include <hip/hip_runtime.h>
#include <cstdio>
#include <cstdint>

#define LAS __attribute__((address_space(3)))
#define GAS __attribute__((address_space(1)))
typedef unsigned short bf16_t;
typedef short bf16x8 __attribute__((ext_vector_type(8)));
typedef short s16x4 __attribute__((ext_vector_type(4)));
typedef float f32x4 __attribute__((ext_vector_type(4)));
typedef float f32x2 __attribute__((ext_vector_type(2)));
typedef float f32x16 __attribute__((ext_vector_type(16)));
typedef unsigned u32x4 __attribute__((ext_vector_type(4)));
typedef unsigned u32x2 __attribute__((ext_vector_type(2)));

typedef __bf16 bf16x2_t __attribute__((ext_vector_type(2)));
__device__ __forceinline__ unsigned cvt_pk_bf16(float lo, float hi) { const f32x2 v = {lo, hi}; const bf16x2_t b = __builtin_convertvector(v, bf16x2_t); return __builtin_bit_cast(unsigned, b); }
__device__ __forceinline__ float bf_lo(unsigned w) { return __uint_as_float(w << 16); }
__device__ __forceinline__ float bf_hi(unsigned w) { return __uint_as_float(w & 0xffff0000u); }
__device__ __forceinline__ float bf2f(bf16_t b) { return __uint_as_float(((unsigned)b) << 16); }
__device__ __forceinline__ bf16_t f2bf(float f) { return (bf16_t)(cvt_pk_bf16(f, 0.f) & 0xffffu); }

namespace pg8 {
constexpr int BM = 256, BK = 64, HALF = 128, HTB = HALF * BK * 2  , STAGE_BYTES = 8 * HTB, NXCD = 8, WGM = 4;
__host__ __device__ __forceinline__ int lds_byte(int r, int c) { const int st = (r >> 4) * 2 + (c >> 5), rr = r & 15, cc = c & 31, ob = rr * 64 + cc * 2; return st * 1024 + (ob ^ (((ob >> 9) & 1) << 5)); }
__host__ __device__ __forceinline__ void stage_rc(int b, int& R, int& C) { const int st = b / 1024, sb = b % 1024, swz = sb ^ (((sb >> 9) & 1) << 5); R = (st >> 1) * 16 + swz / 64; C = (st & 1) * 32 + (swz % 64) / 2; }
__host__ __device__ __forceinline__ int perm32(int rho) { const int n = rho >> 4, i = rho & 15; return 8 * (i >> 2) + 4 * n + (i & 3); }

struct Unit { int pm, pn, pk; };
struct Gemm { const bf16_t* A; const bf16_t* Bt; int M, N, K, lda, ldb, kslice; };

struct StaticOrder {
    int nM, nN, nwg, G, c, wgm;
    __host__ __device__ void init(int M, int N, int G_, int c_, int wgm_ = WGM) { nM = M / BM; nN = N / BM; nwg = nM * nN; G = G_; c = c_; wgm = wgm_; }
    int skip = 0, vc = 0;
    __host__ __device__ bool next(int i, Unit& u) const {
        long L = (long)i * G + c;
        if (skip > 0 && i > 0) { if (vc < skip) return false; L = (long)G + (long)(i - 1) * (G - skip) + (vc - skip); }
        if (L >= nwg) return false;
        int wgid = (int)L; { const int q = nwg / NXCD, r = nwg % NXCD, xcd = wgid % NXCD, off = wgid / NXCD; wgid = (xcd < r ? xcd * (q + 1) : r * (q + 1) + (xcd - r) * q) + off; }
        const int nig = wgm * nN, gid = wgid / nig, fm = gid * wgm, gsz = (nM - fm) < wgm ? (nM - fm) : wgm;
        u.pm = fm + ((wgid % nig) % gsz); u.pn = (wgid % nig) / gsz; u.pk = 0; return true;
    }
    __device__ __forceinline__ void a_ready(const Unit&) const {}
    __device__ __forceinline__ void done(const Unit&) const {}
};


struct SplitOrder {
    int nM, nN, S, G, c;
    __host__ __device__ void init(int M, int N, int S_, int G_, int c_) { nM = M / BM; nN = N / BM; S = S_; G = G_; c = c_; }
    __host__ __device__ bool next(int i, Unit& u) const { const int L = i * G + c; if (L >= nM * nN * S) return false; u.pn = L % nN; u.pm = (L / nN) % nM; u.pk = L / (nN * nM); return true; }
    __device__ __forceinline__ void a_ready(const Unit&) const {}
    __device__ __forceinline__ void done(const Unit&) const {}
};
struct EpiSlab {
    static constexpr bool PERM = true, AFTER_DRAIN = false;
    float* P; int ldc; int rows;
    __device__ __forceinline__ void operator()(const f32x4 (&acc)[2][2][4][2], const Unit& u, int wr, int wc, int fr, int fq) const {
        const int row0 = u.pm * BM + wr * 64 + fr, col0 = u.pn * BM + wc * 32 + 8 * fq;
#pragma unroll
        for (int ai = 0; ai < 2; ++ai)
#pragma unroll
            for (int m = 0; m < 4; ++m) { float* p = P + ((size_t)u.pk * rows + row0 + ai * HALF + m * 16) * ldc + col0;
#pragma unroll
                for (int bj = 0; bj < 2; ++bj) { *(f32x4*)(p + bj * HALF) = acc[ai][bj][m][0]; *(f32x4*)(p + bj * HALF + 4) = acc[ai][bj][m][1]; } }
    }
};

template <int ACT> struct EpiBf16 {
    static constexpr bool PERM = true, AFTER_DRAIN = false;
    const f32x2* rope; int rmode;
    bool nt;
    bf16_t* O; int ldc; const float* RSS;
    __device__ __forceinline__ void rope_load(f32x2 (&cs)[2][2][4], int bt, const int (&tj)[2], int row0) const {
        const int ai = bt >> 1, mp = bt & 1, st = (rmode == 1) ? 1 : 4;
#pragma unroll
        for (int mm = 0; mm < 2; ++mm) { const int mrow = row0 + ai * HALF + (2 * mp + mm) * 16; const int pos = mrow < 32768 ? (mrow & 8191) : 1024 + ((mrow - 32768) & 63);
#pragma unroll
            for (int bj = 0; bj < 2; ++bj) { const f32x2* p = rope + (size_t)pos * 128 + (tj[bj] >= 0 ? tj[bj] : 0);
                if (rmode == 1) { const f32x4 c01 = *(const f32x4*)p, c23 = *(const f32x4*)(p + 2); cs[mm][bj][0] = (f32x2){c01.x, c01.y}; cs[mm][bj][1] = (f32x2){c01.z, c01.w}; cs[mm][bj][2] = (f32x2){c23.x, c23.y}; cs[mm][bj][3] = (f32x2){c23.z, c23.w}; }
                else { cs[mm][bj][0] = p[0]; cs[mm][bj][1] = p[st]; cs[mm][bj][2] = p[2 * st]; cs[mm][bj][3] = p[3 * st]; } } }
    }
    template <bool ROPE>
    __device__ __forceinline__ void body(const f32x4 (&acc)[2][2][4][2], const float (&rsv)[2][4], const int (&tj)[2], const float (&sc)[2], int row0, int col0) const {
        f32x2 csn[2][2][4];
        if constexpr (ROPE) rope_load(csn, 0, tj, row0);
#pragma unroll
        for (int bt = 0; bt < 4; ++bt) { const int ai = bt >> 1, mp = bt & 1;
                f32x2 cs[2][2][4];
                if constexpr (ROPE) {
#pragma unroll
                    for (int mm = 0; mm < 2; ++mm)
#pragma unroll
                        for (int bj = 0; bj < 2; ++bj)
#pragma unroll
                            for (int q = 0; q < 4; ++q) cs[mm][bj][q] = csn[mm][bj][q];
                    if (bt < 3) rope_load(csn, bt + 1, tj, row0); }
#pragma unroll
                for (int mm = 0; mm < 2; ++mm) { const int m = 2 * mp + mm; bf16_t* rowp = O + (size_t)(row0 + ai * HALF + m * 16) * ldc + col0;
                    const float rs = RSS ? 1.0f / sqrtf(rsv[ai][m] * (1.0f / 2048.0f) + 1e-6f) : 1.0f;
#pragma unroll
                    for (int bj = 0; bj < 2; ++bj) { f32x4 v0 = acc[ai][bj][m][0] * rs, v1 = acc[ai][bj][m][1] * rs;
                        if constexpr (ROPE) {
                            const f32x2 c0 = cs[mm][bj][0], c1 = cs[mm][bj][1], c2 = cs[mm][bj][2], c3 = cs[mm][bj][3]; const float s_ = sc[bj]; const bool on = tj[bj] >= 0;
                            const f32x4 a = v0, b = v1;
                            v0[0] = on ? (a[0] * c0.x - a[1] * c0.y) * s_ : a[0]; v0[1] = on ? (a[0] * c0.y + a[1] * c0.x) * s_ : a[1]; v0[2] = on ? (a[2] * c1.x - a[3] * c1.y) * s_ : a[2]; v0[3] = on ? (a[2] * c1.y + a[3] * c1.x) * s_ : a[3];
                            v1[0] = on ? (b[0] * c2.x - b[1] * c2.y) * s_ : b[0]; v1[1] = on ? (b[0] * c2.y + b[1] * c2.x) * s_ : b[1]; v1[2] = on ? (b[2] * c3.x - b[3] * c3.y) * s_ : b[2]; v1[3] = on ? (b[2] * c3.y + b[3] * c3.x) * s_ : b[3];
                        }
                        if (ACT == 1) {
#pragma unroll
                            for (int j = 0; j < 4; ++j) { const float a = fmaxf(v0[j], 0.f), b = fmaxf(v1[j], 0.f); v0[j] = a * a; v1[j] = b * b; } }
                        u32x4 w; w.x = cvt_pk_bf16(v0[0], v0[1]); w.y = cvt_pk_bf16(v0[2], v0[3]); w.z = cvt_pk_bf16(v1[0], v1[1]); w.w = cvt_pk_bf16(v1[2], v1[3]);
                        if (nt) __builtin_nontemporal_store(w, (u32x4*)(rowp + bj * HALF)); else *(u32x4*)(rowp + bj * HALF) = w; } } }
    }
    __device__ __forceinline__ void operator()(const f32x4 (&acc)[2][2][4][2], const Unit& u, int wr, int wc, int fr_, int fq_) const {
        int t2 = threadIdx.x; asm volatile("" : "+v"(t2)); const int fr = t2 & 15, fq = (t2 & 63) >> 4; (void)fr_; (void)fq_;
        const int row0 = u.pm * BM + wr * 64 + fr, col0 = u.pn * BM + wc * 32 + 8 * fq;
        float rsv[2][4];
        { const float* rp = RSS ? RSS + row0 : (const float*)O;
#pragma unroll
        for (int ai = 0; ai < 2; ++ai)
#pragma unroll
            for (int m = 0; m < 4; ++m) rsv[ai][m] = rp[ai * HALF + m * 16]; }
        int tj[2]; float sc[2];
#pragma unroll
        for (int bj = 0; bj < 2; ++bj) { const int col = col0 + bj * HALF; tj[bj] = -1; sc[bj] = 1.0f;
            if (rmode == 1) { if (col < 4096) { tj[bj] = (col & 255) >> 1; sc[bj] = (col >= 2048) ? 0.0625f : 1.0f; } }
            else if (rmode == 2) { const int r = col % 192; if (r >= 128) tj[bj] = 2 * (r - 128); } }
        const bool anyrope = (rmode != 0) && __any((tj[0] >= 0) | (tj[1] >= 0));
        if (anyrope) body<true>(acc, rsv, tj, sc, row0, col0); else body<false>(acc, rsv, tj, sc, row0, col0);
    }
};
struct EpiGlu {
    static constexpr bool PERM = true, AFTER_DRAIN = false;
    bf16_t* O; int ldc; int ocol0; const bf16_t* Z; int ldz; const float* bias;
    __device__ __forceinline__ void operator()(const f32x4 (&acc)[2][2][4][2], const Unit& u, int wr, int wc, int fr, int fq) const {
        const int row0 = u.pm * BM + wr * 64 + fr, col0 = u.pn * BM + wc * 32 + 8 * fq;
        f32x4 bv[2][2];
#pragma unroll
        for (int bj = 0; bj < 2; ++bj)
#pragma unroll
            for (int n = 0; n < 2; ++n) bv[bj][n] = *(const f32x4*)(bias + col0 + bj * HALF + 4 * n);
        u32x4 zq2[2][4][2];
#pragma unroll
        for (int ai = 0; ai < 2; ++ai)
#pragma unroll
            for (int m = 0; m < 4; ++m)
#pragma unroll
                for (int bj = 0; bj < 2; ++bj) zq2[ai][m][bj] = *(const u32x4*)(Z + (size_t)(row0 + ai * HALF + m * 16) * ldz + col0 + bj * HALF);
#pragma unroll
        for (int ai = 0; ai < 2; ++ai) {
            u32x4 zq[4][2];
#pragma unroll
            for (int m = 0; m < 4; ++m)
#pragma unroll
                for (int bj = 0; bj < 2; ++bj) zq[m][bj] = zq2[ai][m][bj];
#pragma unroll
            for (int m = 0; m < 4; ++m) { const size_t r = (size_t)(row0 + ai * HALF + m * 16);
#pragma unroll
                for (int bj = 0; bj < 2; ++bj) { const f32x4 v0 = acc[ai][bj][m][0] + bv[bj][0], v1 = acc[ai][bj][m][1] + bv[bj][1];
                    const u32x4 zz = zq[m][bj];
                    float o[8], zf[8] = {bf_lo(zz.x), bf_hi(zz.x), bf_lo(zz.y), bf_hi(zz.y), bf_lo(zz.z), bf_hi(zz.z), bf_lo(zz.w), bf_hi(zz.w)};
#pragma unroll
                    for (int j = 0; j < 4; ++j) { o[j] = zf[j] / (1.f + __expf(-v0[j])); o[4 + j] = zf[4 + j] / (1.f + __expf(-v1[j])); }
                    u32x4 w; w.x = cvt_pk_bf16(o[0], o[1]); w.y = cvt_pk_bf16(o[2], o[3]); w.z = cvt_pk_bf16(o[4], o[5]); w.w = cvt_pk_bf16(o[6], o[7]);
                    *(u32x4*)(O + r * ldc + ocol0 + col0 + bj * HALF) = w; } } }
    }
};
struct EpiRes {
    static constexpr bool PERM = true, AFTER_DRAIN = false;
    const float* baseP; const bf16_t* baseB; int ldc;
    bf16_t* XB; float* RSS;
    __device__ __forceinline__ void row_out(const f32x4& x, const f32x4& y, bf16_t* p, float& ss) const {
        *(u32x4*)p = (u32x4){cvt_pk_bf16(x[0], x[1]), cvt_pk_bf16(x[2], x[3]), cvt_pk_bf16(y[0], y[1]), cvt_pk_bf16(y[2], y[3])};
        ss += ((x[0] * x[0] + x[1] * x[1]) + (x[2] * x[2] + x[3] * x[3])) + ((y[0] * y[0] + y[1] * y[1]) + (y[2] * y[2] + y[3] * y[3])); }
    __device__ __forceinline__ void row_ss(float ss, int row, int slot, int fq) const {
        ss += __builtin_bit_cast(float, __builtin_amdgcn_ds_swizzle(__builtin_bit_cast(int, ss), 0x401F));
        { const auto rr = __builtin_amdgcn_permlane32_swap(__float_as_uint(ss), __float_as_uint(ss), false, false); ss = __uint_as_float(rr[0]) + __uint_as_float(rr[1]); }
        if (fq == 0) RSS[(size_t)row * 32 + slot] = ss; }
    __device__ __forceinline__ void operator()(const f32x4 (&acc)[2][2][4][2], const Unit& u, int wr, int wc, int fr, int fq) const {
        const int row0 = u.pm * BM + wr * 64 + fr, col0 = u.pn * BM + wc * 32 + 8 * fq;
        if (baseB) { u32x4 w[2][4][2];
#pragma unroll
            for (int ai = 0; ai < 2; ++ai)
#pragma unroll
                for (int m = 0; m < 4; ++m)
#pragma unroll
                    for (int bj = 0; bj < 2; ++bj) w[ai][m][bj] = *(const u32x4*)(baseB + (size_t)(row0 + ai * HALF + m * 16) * ldc + col0 + bj * HALF);
#pragma unroll
            for (int ai = 0; ai < 2; ++ai)
#pragma unroll
                for (int m = 0; m < 4; ++m) { const int row = row0 + ai * HALF + m * 16; float ss = 0.f;
#pragma unroll
                    for (int bj = 0; bj < 2; ++bj) { const u32x4 q = w[ai][m][bj];
                        const f32x4 x = (f32x4){bf_lo(q.x), bf_hi(q.x), bf_lo(q.y), bf_hi(q.y)} + acc[ai][bj][m][0], y = (f32x4){bf_lo(q.z), bf_hi(q.z), bf_lo(q.w), bf_hi(q.w)} + acc[ai][bj][m][1];
                        row_out(x, y, XB + (size_t)row * ldc + col0 + bj * HALF, ss); }
                    row_ss(ss, row, u.pn * 4 + wc, fq); } }
        else {
#pragma unroll
            for (int ai = 0; ai < 2; ++ai)
#pragma unroll
                for (int mp = 0; mp < 2; ++mp) { f32x4 bf[2][2][2];
#pragma unroll
                    for (int mm = 0; mm < 2; ++mm)
#pragma unroll
                        for (int bj = 0; bj < 2; ++bj) { const float* p = baseP + (size_t)(row0 + ai * HALF + (2 * mp + mm) * 16) * ldc + col0 + bj * HALF; bf[mm][bj][0] = *(const f32x4*)p; bf[mm][bj][1] = *(const f32x4*)(p + 4); }
#pragma unroll
                    for (int mm = 0; mm < 2; ++mm) { const int m = 2 * mp + mm; const int row = row0 + ai * HALF + m * 16; float ss = 0.f;
#pragma unroll
                        for (int bj = 0; bj < 2; ++bj) { const f32x4 x = bf[mm][bj][0] + acc[ai][bj][m][0], y = bf[mm][bj][1] + acc[ai][bj][m][1];
                            row_out(x, y, XB + (size_t)row * ldc + col0 + bj * HALF, ss); }
                        row_ss(ss, row, u.pn * 4 + wc, fq); } } }
    }
};

__device__ __forceinline__ void pg8_glds16s(const void* sbase, unsigned voff, unsigned m0v) { unsigned keep;
    const unsigned lo = __builtin_amdgcn_readfirstlane((unsigned)(size_t)sbase), hi = __builtin_amdgcn_readfirstlane((unsigned)((size_t)sbase >> 32));
    const unsigned long long sb = ((unsigned long long)hi << 32) | lo;
    asm volatile("s_mov_b32 %0, m0\n\ts_mov_b32 m0, %3\n\ts_nop 0\n\tglobal_load_lds_dwordx4 %1, %2\n\ts_mov_b32 m0, %0" : "=&s"(keep) : "v"(voff), "s"(sb), "s"(m0v) : "memory"); }
template <class Epi, class Sched, bool ALIGN_EPI = false, bool SP2 = false>
__device__ __forceinline__ void gemm_phase(LAS unsigned char* lds, const Gemm g, const Sched& S_in, const Epi& E) {
    Sched S = S_in; asm volatile("" : "+s"(S.c));
    int tid_ = threadIdx.x; asm volatile("" : "+v"(tid_));
    const int tid = tid_, wid = __builtin_amdgcn_readfirstlane(tid >> 6), lane = tid & 63, wr = wid >> 2, wc = wid & 3, fr = lane & 15, fq = lane >> 4;
    const int K = g.K, nt = K / BK;
    unsigned voffA[2], voffB[2];
#pragma unroll
    for (int i = 0; i < 2; ++i) { int R, C; stage_rc(tid * 16 + i * 8192, R, C); const int Rb = Epi::PERM ? ((R & ~31) + perm32(R & 31)) : R;
        voffA[i] = (unsigned)(R * g.lda + C) * 2u; voffB[i] = (unsigned)(Rb * BK + C) * 2u; }
    const size_t kstep = (size_t)(BK * 2), kstepB = (size_t)(BM * BK * 2);
    const size_t hstepA = (size_t)HALF * g.lda * 2, hstepB = (size_t)HALF * BK * 2;
    const size_t tstepA = 2 * hstepA, tstepB = (size_t)(g.ldb / BK) * (BM * BK * 2);
    const unsigned ldsbase_ = (unsigned)(size_t)lds;
    const unsigned ldsw = (unsigned)wid * 1024u;
    const int aoff = lds_byte(wr * 64 + fr, fq * 8), boff = lds_byte(wc * 32 + fr, fq * 8);
#define PG8_SA(b, h) (((b) * 2 + (h)) * HTB)
#define PG8_SB(b, h) ((4 + (b) * 2 + (h)) * HTB)
#define PG8_STAGE(bufoff, gbase, voff) do { _Pragma("unroll") for (int _i = 0; _i < 2; ++_i) \
        pg8_glds16s((gbase), (voff)[_i], (unsigned)__builtin_amdgcn_readfirstlane((int)(ldsbase_ + (bufoff) + ldsw + _i * 8192))); } while (0)
#define PG8_LDA(dst, b, h) do { _Pragma("unroll") for (int m = 0; m < 4; ++m) _Pragma("unroll") for (int k = 0; k < 2; ++k) dst[m][k] = *(const LAS bf16x8*)(lds + PG8_SA(b, h) + aoff + m * 2048 + k * 1024); } while (0)
#define PG8_LDB(dst, b, h) do { _Pragma("unroll") for (int n = 0; n < 2; ++n) _Pragma("unroll") for (int k = 0; k < 2; ++k) dst[n][k] = *(const LAS bf16x8*)(lds + PG8_SB(b, h) + boff + n * 2048 + k * 1024); } while (0)
#define PG8_MMA(ai, bj, At, Bt) do { __builtin_amdgcn_s_setprio(1); _Pragma("unroll") for (int m = 0; m < 4; ++m) _Pragma("unroll") for (int n = 0; n < 2; ++n) _Pragma("unroll") for (int k = 0; k < 2; ++k) \
        acc[ai][bj][m][n] = __builtin_amdgcn_mfma_f32_16x16x32_bf16(Bt[n][k], At[m][k], acc[ai][bj][m][n], 0, 0, 0); __builtin_amdgcn_s_setprio(0); } while (0)
#define PG8_WAIT_V(n) asm volatile("s_waitcnt vmcnt(" #n ")" ::: "memory")
#define PG8_WAIT_L(n) asm volatile("s_waitcnt lgkmcnt(" #n ")" ::: "memory")
#define PG8_BAR __builtin_amdgcn_s_barrier()
#define PG8_SCHED __builtin_amdgcn_sched_barrier(0)
    Unit cur, nxt; int ui = 0;
    if (!S.next(0, cur)) return;
    f32x4 acc[2][2][4][2];
#pragma unroll
    for (int a = 0; a < 2; ++a)
#pragma unroll
        for (int b = 0; b < 2; ++b)
#pragma unroll
            for (int m = 0; m < 4; ++m)
#pragma unroll
                for (int n = 0; n < 2; ++n) acc[a][b][m][n] = (f32x4){0.f, 0.f, 0.f, 0.f};
    bf16x8 At[4][2], B0[2][2], B1[2][2];
    const size_t ksb = (size_t)g.kslice * 2, ksbB = (size_t)(g.kslice / BK) * (BM * BK * 2);
    const char* cA = (const char*)g.A + (size_t)cur.pm * tstepA + cur.pk * ksb; const char* cB = (const char*)g.Bt + (size_t)cur.pn * tstepB + cur.pk * ksbB;
    S.a_ready(cur);
    if constexpr (SP2) {
        PG8_STAGE(PG8_SB(0, 0), cB, voffB); PG8_STAGE(PG8_SB(0, 1), cB + hstepB, voffB); PG8_STAGE(PG8_SA(0, 0), cA, voffA); PG8_STAGE(PG8_SA(0, 1), cA + hstepA, voffA);
        if (wr == 1) PG8_BAR;
        PG8_WAIT_V(2); PG8_BAR;
        PG8_STAGE(PG8_SB(1, 0), cB + kstepB, voffB); PG8_STAGE(PG8_SA(1, 0), cA + kstep, voffA); PG8_STAGE(PG8_SB(1, 1), cB + hstepB + kstepB, voffB);
        PG8_WAIT_V(6); PG8_BAR;
    } else {
        PG8_STAGE(PG8_SB(0, 0), cB, voffB); PG8_STAGE(PG8_SA(0, 0), cA, voffA); PG8_STAGE(PG8_SB(0, 1), cB + hstepB, voffB); PG8_STAGE(PG8_SA(0, 1), cA + hstepA, voffA);
        if (wr == 1) PG8_BAR;
        PG8_WAIT_V(4); PG8_BAR;
        PG8_STAGE(PG8_SB(1, 0), cB + kstepB, voffB); PG8_STAGE(PG8_SA(1, 0), cA + kstep, voffA); PG8_STAGE(PG8_SB(1, 1), cB + hstepB + kstepB, voffB);
        PG8_WAIT_V(6); PG8_BAR;
    }
    for (;;) {
        const bool has_next = S.next(ui + 1, nxt);
        const char* nA = has_next ? (const char*)g.A + (size_t)nxt.pm * tstepA + nxt.pk * ksb : cA; const char* nB = has_next ? (const char*)g.Bt + (size_t)nxt.pn * tstepB + nxt.pk * ksbB : cB;
        for (int t = 0; t < nt; t += 2) {
            const bool last = (t == nt - 2);
            const char* a1 = cA + (size_t)(t + 1) * kstep;
            const char* a2 = last ? nA : cA + (size_t)(t + 2) * kstep; const char* b2 = last ? nB : cB + (size_t)(t + 2) * kstepB;
            const char* a3 = a2 + kstep; const char* b3 = b2 + kstepB;
            if (last && has_next) S.a_ready(nxt);
            if constexpr (SP2) {
            PG8_LDB(B0, 0, 0); PG8_LDB(B1, 0, 1); PG8_SCHED; PG8_LDA(At, 0, 0); PG8_STAGE(PG8_SA(1, 1), a1 + hstepA, voffA);
            PG8_WAIT_V(8); PG8_WAIT_L(0); PG8_BAR; PG8_MMA(0, 0, At, B0); PG8_MMA(0, 1, At, B1); PG8_BAR; PG8_SCHED;
            PG8_LDA(At, 0, 1); PG8_STAGE(PG8_SB(0, 0), b2, voffB); PG8_STAGE(PG8_SB(0, 1), b2 + hstepB, voffB); PG8_STAGE(PG8_SA(0, 0), a2, voffA);
            PG8_WAIT_V(8); PG8_WAIT_L(0); PG8_BAR; PG8_MMA(1, 0, At, B0); PG8_MMA(1, 1, At, B1); PG8_BAR; PG8_SCHED;
            PG8_LDB(B0, 1, 0); PG8_LDB(B1, 1, 1); PG8_SCHED; PG8_LDA(At, 1, 0); PG8_STAGE(PG8_SA(0, 1), a2 + hstepA, voffA);
            PG8_WAIT_V(8); PG8_WAIT_L(0); PG8_BAR; PG8_MMA(0, 0, At, B0); PG8_MMA(0, 1, At, B1); PG8_BAR; PG8_SCHED;
            PG8_LDA(At, 1, 1); PG8_STAGE(PG8_SB(1, 0), b3, voffB); PG8_STAGE(PG8_SB(1, 1), b3 + hstepB, voffB); PG8_STAGE(PG8_SA(1, 0), a3, voffA);
            PG8_WAIT_V(8); PG8_WAIT_L(0); PG8_BAR; PG8_MMA(1, 0, At, B0); PG8_MMA(1, 1, At, B1); PG8_BAR; PG8_SCHED;
            } else {
            PG8_LDB(B0, 0, 0); PG8_SCHED; PG8_LDA(At, 0, 0); PG8_STAGE(PG8_SA(1, 1), a1 + hstepA, voffA);
            PG8_WAIT_L(8); PG8_BAR; PG8_WAIT_L(0); PG8_MMA(0, 0, At, B0); PG8_BAR; PG8_SCHED;
            PG8_LDB(B1, 0, 1); PG8_STAGE(PG8_SB(0, 0), b2, voffB);
            PG8_BAR; PG8_WAIT_L(0); PG8_MMA(0, 1, At, B1); PG8_BAR;
            PG8_LDA(At, 0, 1); PG8_STAGE(PG8_SA(0, 0), a2, voffA);
            PG8_BAR; PG8_WAIT_L(0); PG8_MMA(1, 0, At, B0); PG8_BAR; PG8_SCHED;
            PG8_STAGE(PG8_SB(0, 1), b2 + hstepB, voffB);
            PG8_WAIT_V(6); PG8_BAR; PG8_MMA(1, 1, At, B1); PG8_BAR;
            PG8_LDB(B0, 1, 0); PG8_SCHED; PG8_LDA(At, 1, 0); PG8_STAGE(PG8_SA(0, 1), a2 + hstepA, voffA);
            PG8_WAIT_L(8); PG8_BAR; PG8_WAIT_L(0); PG8_MMA(0, 0, At, B0); PG8_BAR; PG8_SCHED;
            PG8_LDB(B1, 1, 1); PG8_STAGE(PG8_SB(1, 0), b3, voffB);
            PG8_BAR; PG8_WAIT_L(0); PG8_MMA(0, 1, At, B1); PG8_BAR;
            PG8_LDA(At, 1, 1); PG8_STAGE(PG8_SA(1, 0), a3, voffA);
            PG8_BAR; PG8_WAIT_L(0); PG8_MMA(1, 0, At, B0); PG8_BAR; PG8_SCHED;
            PG8_STAGE(PG8_SB(1, 1), b3 + hstepB, voffB);
            PG8_WAIT_V(6); PG8_BAR; PG8_MMA(1, 1, At, B1); PG8_BAR;
            }
        }
        if constexpr (ALIGN_EPI) { if (wr == 0) PG8_BAR; }
        if constexpr (!Epi::AFTER_DRAIN) { E(acc, cur, wr, wc, fr, fq); S.done(cur); }
        if (!has_next) break;
#pragma unroll
        for (int a = 0; a < 2; ++a)
#pragma unroll
            for (int b = 0; b < 2; ++b)
#pragma unroll
                for (int m = 0; m < 4; ++m)
#pragma unroll
                    for (int n = 0; n < 2; ++n) acc[a][b][m][n] = (f32x4){0.f, 0.f, 0.f, 0.f};
        cur = nxt; cA = nA; cB = nB; ++ui;
        if constexpr (ALIGN_EPI) { if (wr == 1) PG8_BAR; }
    }
    PG8_WAIT_V(0);
    if constexpr (!ALIGN_EPI) { if (wr == 0) PG8_BAR; }
    PG8_BAR;
    if constexpr (Epi::AFTER_DRAIN) { E.fused(acc, cur, wr, wc, fr, fq, lds, wid, lane); S.done(cur); }
#undef PG8_SA
#undef PG8_SB
#undef PG8_STAGE
#undef PG8_LDA
#undef PG8_LDB
#undef PG8_MMA
#undef PG8_WAIT_V
#undef PG8_WAIT_L
#undef PG8_BAR
#undef PG8_SCHED
}
}
#define XB_TMO      128
#define XB_XCNT(j)  (256  + 64 * (j))
#define XB_XSUB(j)  (1280 + 64 * (j))
#define XB_XGEN(j)  (2304 + 64 * (j))
#define XB_TOP      3328
#define XB_TOPGEN   3392
#define XCD_BAR_WORDS 3456
#define XB_SPIN_CAP (1u << 18)

__device__ __forceinline__ unsigned xb_ld(unsigned* p)              { return __hip_atomic_load(p, __ATOMIC_RELAXED, __HIP_MEMORY_SCOPE_AGENT); }
__device__ __forceinline__ unsigned xb_add(unsigned* p, unsigned v) { return __hip_atomic_fetch_add(p, v, __ATOMIC_RELAXED, __HIP_MEMORY_SCOPE_AGENT); }
__device__ __forceinline__ unsigned xb_xcc_id() { return (unsigned)__builtin_amdgcn_s_getreg((3 << 11) | 20) & 0xFu; }
#define XB_SPIN(cond, bar) do { unsigned _sp = 0; while (cond) { __builtin_amdgcn_s_sleep(1); \
    if ((++_sp & 255u) == 0u) { if (xb_ld(&(bar)[XB_TMO])) break; if (_sp > XB_SPIN_CAP) { atomicAdd(&(bar)[XB_TMO], 1u); break; } } } } while (0)

struct XcdBarrier {
    unsigned* bar; unsigned x;
    volatile LAS unsigned* st;
};

__device__ __forceinline__ XcdBarrier xcd_barrier_post(unsigned* bar, volatile LAS unsigned* st) {
    XcdBarrier b; b.bar = bar; b.x = xb_xcc_id(); b.st = st;
    if (threadIdx.x == 0) (void)xb_add(&bar[XB_XCNT(b.x)], 1u);
    return b;
}
__device__ __forceinline__ void xcd_barrier_complete(unsigned* bar, unsigned x, unsigned& nloc, unsigned& nx) {
    const unsigned G = gridDim.x * gridDim.y * gridDim.z;
    unsigned sum, cnt, mine, sp = 0u;
    for (;;) {
        sum = 0u; cnt = 0u; mine = 0u;
#pragma unroll
        for (unsigned j = 0; j < 16; ++j) { const unsigned c = xb_ld(&bar[XB_XCNT(j)]); sum += c; cnt += (c > 0u) ? 1u : 0u; mine = (j == x) ? c : mine; }
        if (sum == G) break;
        __builtin_amdgcn_s_sleep(1);
        if ((++sp & 255u) == 0u) { if (xb_ld(&bar[XB_TMO])) break; if (sp > XB_SPIN_CAP) { atomicAdd(&bar[XB_TMO], 1u); break; } }
    }
    nloc = mine > 0u ? mine : 1u; nx = cnt > 0u ? cnt : 1u;
}

__device__ __forceinline__ void xcd_barrier(const XcdBarrier& b) {
    asm volatile("s_waitcnt vmcnt(0)" ::: "memory");
    __syncthreads();
    if (threadIdx.x == 0) {
        unsigned* bar = b.bar;
        __builtin_amdgcn_s_waitcnt(0);
        unsigned nloc = b.st[0], nx = b.st[1];
        if (nloc == 0u) { xcd_barrier_complete(bar, b.x, nloc, nx); b.st[0] = nloc; b.st[1] = nx; }
        const unsigned old = xb_add(&bar[XB_XSUB(b.x)], 1u);
        const unsigned gen = old / nloc;
        if (old + 1u == (gen + 1u) * nloc) {
            __builtin_amdgcn_fence(__ATOMIC_RELEASE, "agent");
            asm volatile("s_waitcnt vmcnt(0)" ::: "memory");
            const unsigned og = xb_add(&bar[XB_TOP], 1u);
            const unsigned tg = og / nx;
            if (og + 1u == (tg + 1u) * nx) xb_add(&bar[XB_TOPGEN], 1u);
            else XB_SPIN(xb_ld(&bar[XB_TOPGEN]) == tg, bar);
            __builtin_amdgcn_fence(__ATOMIC_ACQUIRE, "agent");
            xb_add(&bar[XB_XGEN(b.x)], 1u);
            asm volatile("s_waitcnt vmcnt(0)" ::: "memory");
        } else {
            XB_SPIN(xb_ld(&bar[XB_XGEN(b.x)]) == gen, bar);
            __builtin_amdgcn_fence(__ATOMIC_ACQUIRE, "agent");
            asm volatile("s_waitcnt vmcnt(0)" ::: "memory");
        }
    }
    __syncthreads();
}


constexpr int DM = 2048, NB = 4, SEQ = 8192, DEPTH = 4, DB = 8, DS = 64, PAST = 1024;
constexpr int MP = NB * SEQ, MS = DB * DS, M = MP + MS;
constexpr int KEYS_S = PAST + DS, KROWS = MP + DB * KEYS_S;
constexpr int QL = 512, KVL = 256, ROPE = 64, S5W = 1024, INAB = 1856, INABP = 2048;
constexpr int C_CQ = 0, C_CKV = 512, C_KR = 768, C_U = 832;
constexpr int NH = 8, QHD = 192, QW = NH * QHD, KVW = NH * 256;
constexpr int S5G = 64, S5N = 64, S5P = 16;
constexpr int RH = 8, RDK = 256, RDV = 512, INC = 12288, C_RQ = 0, C_RK = 2048, C_RV = 4096, C_RG = 8192;
constexpr int FF = 8192;
constexpr float EPS = 1e-6f, GN_EPS = 1e-5f;
constexpr int NWAVES = 8, NTHREADS = 512;

constexpr size_t O_Y = 0;
constexpr size_t O_CKV_P = (size_t)M * DM;
constexpr size_t O_KR_P = O_CKV_P + (size_t)2 * MP * KVL;
constexpr size_t O_S5RE_P = O_KR_P + (size_t)2 * MP * ROPE;
constexpr size_t O_S5IM_P = O_S5RE_P + (size_t)2 * NB * S5G * S5N;
constexpr size_t O_RET_P = O_S5IM_P + (size_t)2 * NB * S5G * S5N;
constexpr size_t O_CKV_S = O_RET_P + (size_t)2 * NB * RH * RDK * RDV;
constexpr size_t O_KR_S = O_CKV_S + (size_t)2 * MS * KVL;
constexpr size_t O_S5RE_S = O_KR_S + (size_t)2 * MS * ROPE;
constexpr size_t O_S5IM_S = O_S5RE_S + (size_t)2 * DB * S5G * S5N;
constexpr size_t O_RET_S = O_S5IM_S + (size_t)2 * DB * S5G * S5N;
constexpr size_t O_END = O_RET_S + (size_t)2 * DB * RH * RDK * RDV;
static_assert(O_END == 114819072, "d_out size");

constexpr size_t MiB = (size_t)1 << 20;
constexpr size_t WS_CTL = 0, CTL_ZERO_BYTES = 64 * 1024;
constexpr size_t WS_ROPE = 1 * MiB;
constexpr size_t WS_S5TAB = 9 * MiB, S5TAB_STRIDE = 1 * MiB;
constexpr size_t S5T_A = 0, S5T_B = 65536, S5T_C = 65536 + 262144;
constexpr size_t WS_S5CAR = 11 * MiB;
constexpr size_t WS_RSS = 27 * MiB, RSS_BANK = 256 * 1024, WS_RSSP = 27 * MiB + 512 * 1024;
static_assert(WS_RSSP + (size_t)M * 128 <= 32 * MiB, "rssp");
constexpr size_t WS_W = 32 * MiB, W_BUF = 0;
constexpr size_t W_UP = 0, W_DOWN = 32 * MiB, W_MIX = 64 * MiB;
constexpr size_t W_INAB = W_MIX, W_QB = W_MIX + 8 * MiB, W_KVB = W_MIX + 10 * MiB, W_GLU = W_MIX + 12 * MiB, W_OUTAB = W_MIX + 14 * MiB;
constexpr size_t W_INC = W_MIX, W_OUTC = W_MIX + 48 * MiB;
constexpr size_t WS_ACT = 160 * MiB;
constexpr size_t A_H = 0;
constexpr size_t A_FF = 130 * MiB;
constexpr size_t A_INAB = 130 * MiB, A_CQN = 260 * MiB, A_ACKV = 293 * MiB, A_AKR = 314 * MiB, A_Q = 320 * MiB, A_KV = 418 * MiB, A_MIX = 580 * MiB, A_Z = 710 * MiB;
constexpr size_t A_INC = 130 * MiB;
constexpr size_t A_PART = 840 * MiB;
constexpr size_t WS_END = WS_ACT + 910 * MiB;
static_assert(A_INAB + (size_t)M * INABP * 2 <= A_CQN && A_CQN + (size_t)M * QL * 2 <= A_ACKV && A_ACKV + (size_t)KROWS * KVL * 2 <= A_AKR && A_AKR + (size_t)KROWS * ROPE * 2 <= A_Q &&
              A_Q + (size_t)M * QW * 2 <= A_KV && A_KV + (size_t)KROWS * KVW * 2 <= A_MIX && A_MIX + (size_t)M * DM * 2 <= A_Z && A_Z + (size_t)M * S5W * 2 <= 910 * MiB &&
              A_INC + (size_t)M * INC * 2 <= 910 * MiB && A_FF + (size_t)M * FF * 2 <= 910 * MiB && (size_t)M * DM * 2 <= A_FF, "activation map");
constexpr int CW_BAR = 1024;
static_assert((CW_BAR + XCD_BAR_WORDS) * 4 <= (int)CTL_ZERO_BYTES, "ctl");

constexpr int LDS_MAIN = 139264;
constexpr int LDSCTL_OFF = LDS_MAIN;
constexpr int LDS_BYTES = 147456;

struct Args { const float* in[31]; float* out; unsigned char* ws; int ph_lo, ph_hi; };
struct Ctx { unsigned char* ws; float* out; };
template <class T> __device__ __forceinline__ T* as_global(T* p) { GAS T* g = (GAS T*)p; asm("" : "+s"(g)); return (T*)g; }
template <class T> __device__ __forceinline__ T* opaque(T* p) { GAS T* g = (GAS T*)p; asm volatile("" : "+s"(g)); return (T*)g; }
__device__ __forceinline__ const float* arg_in(int k) {
    int off = k * 8; asm volatile("" : "+s"(off));
    return as_global(*(const float* const __attribute__((address_space(4)))*)((const __attribute__((address_space(4))) char*)__builtin_amdgcn_kernarg_segment_ptr() + off));
}

__device__ __forceinline__ float wave_sum(float v) {
#define WS_SWZ(pat) v += __builtin_bit_cast(float, __builtin_amdgcn_ds_swizzle(__builtin_bit_cast(int, v), pat))
    WS_SWZ(0x041F); WS_SWZ(0x081F); WS_SWZ(0x101F); WS_SWZ(0x201F); WS_SWZ(0x401F);
#undef WS_SWZ
    const auto rr = __builtin_amdgcn_permlane32_swap(__float_as_uint(v), __float_as_uint(v), false, false);
    return __uint_as_float(rr[0]) + __uint_as_float(rr[1]);
}
#define LDS_WAIT() asm volatile("s_waitcnt lgkmcnt(0)" ::: "memory")
#define VM_WAIT() asm volatile("s_waitcnt vmcnt(0)" ::: "memory")

__device__ __forceinline__ void sincos_d(double a, double& s, double& c) {
    const double k = rint(a * 0.63661977236758134308);
    double y = fma(-k, 1.57079632679489655800, a); y = fma(-k, 6.123233995736766e-17, y);
    const double y2 = y * y;
    double sp = -7.6471637318198164759e-13; sp = fma(sp, y2, 1.6059043836821614599e-10); sp = fma(sp, y2, -2.5052108385441718775e-8); sp = fma(sp, y2, 2.7557319223985890653e-6);
    sp = fma(sp, y2, -1.9841269841269841270e-4); sp = fma(sp, y2, 8.3333333333333333333e-3); sp = fma(sp, y2, -1.6666666666666666667e-1); const double sy = fma(sp * y2, y, y);
    double cp = 4.7794773323873852974e-14; cp = fma(cp, y2, -1.1470745597729724714e-11); cp = fma(cp, y2, 2.0876756987868098979e-9); cp = fma(cp, y2, -2.7557319223985890653e-7);
    cp = fma(cp, y2, 2.4801587301587301587e-5); cp = fma(cp, y2, -1.3888888888888888889e-3); cp = fma(cp, y2, 4.1666666666666666667e-2); cp = fma(cp, y2, -0.5); const double cy = fma(cp, y2, 1.0);
    const int q = ((int)k) & 3;
    s = (q == 0) ? sy : (q == 1) ? cy : (q == 2) ? -sy : -cy;
    c = (q == 0) ? cy : (q == 1) ? -sy : (q == 2) ? -cy : sy;
}

__device__ __forceinline__ int row_pos(int m) { return m < MP ? (m & (SEQ - 1)) : PAST + ((m - MP) & (DS - 1)); }
__device__ __forceinline__ int row_key(int m) { return m < MP ? m : MP + ((m - MP) >> 6) * KEYS_S + PAST + ((m - MP) & (DS - 1)); }

__device__ __forceinline__ void ph_tables(const Ctx& a, int gthreads) {
    int tid_ = threadIdx.x; asm volatile("" : "+v"(tid_)); const int gtid = blockIdx.x * NTHREADS + tid_;
    f32x2* rope = (f32x2*)(a.ws + WS_ROPE);
    for (int e = gtid; e < SEQ * 128; e += gthreads) {
        const int pos = e >> 7, j = e & 127;
        const double inv = exp(-(double)j * (9.210340371976182736 / 128.0));
        double s, c; sincos_d((double)pos * inv, s, c);
        rope[e] = (f32x2){(float)c, (float)s};
    }
    for (int e = gtid; e < 2 * S5G * S5N; e += gthreads) {
        const int i = e >> 12, g = (e >> 6) & 63, n = e & 63;
        unsigned char* tab = a.ws + WS_S5TAB + (size_t)i * S5TAB_STRIDE;
        const double lr = fmin((double)arg_in(15)[e], -1e-4), li = (double)arg_in(16)[e];
        const double dt = exp((double)arg_in(17)[i * S5G + g]);
        const double mag = exp(lr * dt); double sn, cs; sincos_d(li * dt, sn, cs);
        const double are = mag * cs, aim = mag * sn, den = lr * lr + li * li;
        const double fre = ((are - 1.0) * lr + aim * li) / den, fim = (aim * lr - (are - 1.0) * li) / den;
        double pr = are, pi = aim;
#pragma unroll
        for (int k = 0; k < 6; ++k) { const double nr = pr * pr - pi * pi, ni = 2.0 * pr * pi; pr = nr; pi = ni; }
        ((f32x4*)(tab + S5T_A))[g * S5N + n] = (f32x4){(float)are, (float)aim, (float)pr, (float)pi};
        bf16_t* bbt = (bf16_t*)(tab + S5T_B); bf16_t* cmt = (bf16_t*)(tab + S5T_C);
        const float* bre = arg_in(18) + (size_t)e * S5P; const float* bim = arg_in(19) + (size_t)e * S5P;
        const float* cre = arg_in(20) + ((size_t)i * S5G + g) * S5P * S5N + n; const float* cim = arg_in(21) + ((size_t)i * S5G + g) * S5P * S5N + n;
        f32x4 brv[4], biv[4]; float crv[16], civ[16];
#pragma unroll
        for (int q = 0; q < 4; ++q) { brv[q] = *(const f32x4*)(bre + 4 * q); biv[q] = *(const f32x4*)(bim + 4 * q); }
#pragma unroll
        for (int p = 0; p < S5P; ++p) { crv[p] = cre[(size_t)p * S5N]; civ[p] = cim[(size_t)p * S5N]; }
#pragma unroll
        for (int p = 0; p < S5P; ++p) {
            const double br = brv[p >> 2][p & 3], bi = biv[p >> 2][p & 3];
            bbt[((size_t)g * 128 + n) * 16 + p] = f2bf((float)(fre * br - fim * bi));
            bbt[((size_t)g * 128 + 64 + n) * 16 + p] = f2bf((float)(fre * bi + fim * br));
            cmt[((size_t)g * 16 + p) * 128 + n] = f2bf(crv[p]);
            cmt[((size_t)g * 16 + p) * 128 + 64 + n] = f2bf(-civ[p]);
        }
    }
}

__device__ __forceinline__ int wrow_perm(int n, int pm) {
    if (pm == 1) return (n < 4096) ? ((n & ~255) | ((n & 127) << 1) | ((n >> 7) & 1)) : n;
    if (pm == 2) { const int h = n / 192, r = n - h * 192; return (r < 128) ? n : h * 192 + 128 + (((r - 128) & 31) << 1) + ((r - 128) >> 5); }
    return n;
}
__device__ __forceinline__ void transpose_item(const float* W, int K, int N, bf16_t* WT, LAS float* scr, int item, int lane, const float* gk, int pm) {
    const int nblk = N / 32, kb = item / nblk, nb = item % nblk, k0 = 64 * kb, n0 = 32 * nb;
#pragma unroll 8
    for (int i = 0; i < 32; ++i) { const int kk = 2 * i + (lane >> 5); scr[kk * 33 + (lane & 31)] = W[(size_t)(k0 + kk) * N + n0 + (lane & 31)]; }
    LDS_WAIT(); asm volatile("" ::: "memory");
    const int c = lane & 7;
    f32x4 g0 = {1.f, 1.f, 1.f, 1.f}, g1 = g0;
    if (gk) { g0 = *(const f32x4*)(gk + k0 + 8 * c); g1 = *(const f32x4*)(gk + k0 + 8 * c + 4); }
#pragma unroll
    for (int j = 0; j < 4; ++j) { const int n = (lane >> 3) + 8 * j; const LAS float* s = scr + (8 * c) * 33 + n;
        u32x4 o; o.x = cvt_pk_bf16(s[0 * 33] * g0.x, s[1 * 33] * g0.y); o.y = cvt_pk_bf16(s[2 * 33] * g0.z, s[3 * 33] * g0.w); o.z = cvt_pk_bf16(s[4 * 33] * g1.x, s[5 * 33] * g1.y); o.w = cvt_pk_bf16(s[6 * 33] * g1.z, s[7 * 33] * g1.w);
        const int nr = wrow_perm(n0 + n, pm);
        *(u32x4*)(WT + ((size_t)(nr >> 8) * (K >> 6) + (k0 >> 6)) * 16384 + (size_t)(nr & 255) * 64 + 8 * c) = o; }
    LDS_WAIT(); asm volatile("" ::: "memory");
}
__device__ __forceinline__ int convert_items(int L) { return 16384 + (((L & 1) == 0) ? (DM / 64) * (INAB / 32) + (QL / 64) * (QW / 32) + (KVL / 64) * (KVW / 32) + (S5W / 64) * (S5W / 32) + (DM / 64) * (DM / 32) : (DM / 64) * (INC / 32) + (4096 / 64) * (DM / 32)); }
__device__ __forceinline__ void ph_convert(const Ctx& a, int L, LAS unsigned char* lds, int i0, int i1, int pblk0, int G) {
    int tid_ = threadIdx.x; asm volatile("" : "+v"(tid_)); const int lane = tid_ & 63, wave = __builtin_amdgcn_readfirstlane(tid_ >> 6);
    if ((int)blockIdx.x < pblk0) return;
    const int gw = ((int)blockIdx.x - pblk0) * NWAVES + wave, NGW = (G - pblk0) * NWAVES;
    LAS float* scr = (LAS float*)(lds + wave * 16384);
    unsigned char* wb = a.ws + WS_W + (size_t)(L & 1) * W_BUF;
    const int i = L >> 1; const bool even = (L & 1) == 0;
    constexpr int I_UP = (DM / 64) * (FF / 32), I_DN = (FF / 64) * (DM / 32);
    constexpr int IE_IN = (DM / 64) * (INAB / 32), IE_QB = (QL / 64) * (QW / 32), IE_KVB = (KVL / 64) * (KVW / 32), IE_GLU = (S5W / 64) * (S5W / 32), IE_OUT = (DM / 64) * (DM / 32);
    constexpr int IO_IN = (DM / 64) * (INC / 32), IO_OUT = (4096 / 64) * (DM / 32);
    const int nit = I_UP + I_DN + (even ? IE_IN + IE_QB + IE_KVB + IE_GLU + IE_OUT : IO_IN + IO_OUT);
    const int iend = i1 < nit ? i1 : nit;
    for (int it = i0 + gw; it < iend; it += NGW) {
        int r = it; const float* W; int K, N; size_t wo; const float* gk = nullptr; int pm = 0;
        if (r < I_UP) { W = arg_in(29) + (size_t)L * DM * FF; K = DM; N = FF; wo = W_UP; gk = arg_in(8) + L * DM; }
        else if ((r -= I_UP) < I_DN) { W = arg_in(30) + (size_t)L * FF * DM; K = FF; N = DM; wo = W_DOWN; }
        else if (even) {
            r -= I_DN;
            if (r < IE_IN) { W = arg_in(10) + (size_t)i * DM * INAB; K = DM; N = INAB; wo = W_INAB; gk = arg_in(7) + L * DM; }
            else if ((r -= IE_IN) < IE_QB) { W = arg_in(13) + (size_t)i * QL * QW; K = QL; N = QW; wo = W_QB; pm = 2; }
            else if ((r -= IE_QB) < IE_KVB) { W = arg_in(14) + (size_t)i * KVL * KVW; K = KVL; N = KVW; wo = W_KVB; }
            else if ((r -= IE_KVB) < IE_GLU) { W = arg_in(23) + (size_t)i * S5W * S5W; K = S5W; N = S5W; wo = W_GLU; }
            else { r -= IE_GLU; W = arg_in(25) + (size_t)i * DM * DM; K = DM; N = DM; wo = W_OUTAB; }
        } else {
            r -= I_DN;
            if (r < IO_IN) { W = arg_in(26) + (size_t)i * DM * INC; K = DM; N = INC; wo = W_INC; gk = arg_in(7) + L * DM; pm = 1; }
            else { r -= IO_IN; W = arg_in(28) + (size_t)i * 4096 * DM; K = 4096; N = DM; wo = W_OUTC; }
        }
        transpose_item(W, K, N, (bf16_t*)(wb + wo), scr, r, lane, gk, pm);
    }
    if (even && i1 >= nit) {
        unsigned zz = 0u; asm volatile("" : "+v"(zz));
        constexpr int NCH = (INABP - INAB) * DM / 8;
        for (int e = gw * 64 + lane; e < NCH; e += NGW * 64) { const int nr = INAB + e / (DM / 8), k = (e % (DM / 8)) * 8;
            *(u32x4*)((bf16_t*)(wb + W_INAB) + ((size_t)(nr >> 8) * (DM >> 6) + (k >> 6)) * 16384 + (size_t)(nr & 255) * 64 + (k & 63)) = (u32x4){zz, zz, zz, zz}; }
    }
}


__device__ __forceinline__ void add_slabs(f32x4 (&v)[8], const float* part, int ns, int ms, int lane) {
    const float* pr = part + (size_t)ms * DM + 4 * lane;
    for (int sl = 0; sl < ns; sl += 4) {
        f32x4 t[4][8];
#pragma unroll
        for (int q = 0; q < 4; ++q)
#pragma unroll
            for (int j = 0; j < 8; ++j) t[q][j] = *(const f32x4*)(pr + (size_t)(sl + q) * MS * DM + 256 * j);
        __builtin_amdgcn_sched_barrier(0);
#pragma unroll
        for (int j = 0; j < 8; ++j) v[j] += (t[0][j] + t[1][j]) + (t[2][j] + t[3][j]);
        __builtin_amdgcn_sched_barrier(0);
    }
}
__device__ __forceinline__ void ph_xprep(const float* xp, const float* xs_adj, bf16_t* XB, float* RSS, int r0, int r1, int NGW, const float* part, int ns, float* xw, const float* rssp) {
    int tid_ = threadIdx.x; asm volatile("" : "+v"(tid_)); const int lane = tid_ & 63, wave = __builtin_amdgcn_readfirstlane(tid_ >> 6), gw = blockIdx.x * NWAVES + wave;
    if (rssp != nullptr)
        for (int m = blockIdx.x * NTHREADS + tid_; m < MP; m += gridDim.x * NTHREADS) { const f32x4* p = (const f32x4*)(rssp + (size_t)m * 32); f32x4 a = p[0];
#pragma unroll
            for (int j = 1; j < 8; ++j) a += p[j];
            RSS[m] = (a.x + a.y) + (a.z + a.w); }
    f32x4 vn[8];
    if (r0 + gw < r1) { const int m = r0 + gw; const float* xr = ((m < MP) ? xp : xs_adj) + (size_t)m * DM;
#pragma unroll
        for (int j = 0; j < 8; ++j) vn[j] = *(const f32x4*)(xr + 4 * lane + 256 * j); }
    for (int m = r0 + gw; m < r1; m += NGW) {
        f32x4 v[8]; float s = 0.f;
#pragma unroll
        for (int j = 0; j < 8; ++j) v[j] = vn[j];
        if (m + NGW < r1) { const int mn = m + NGW; const float* xr = ((mn < MP) ? xp : xs_adj) + (size_t)mn * DM;
#pragma unroll
            for (int j = 0; j < 8; ++j) vn[j] = *(const f32x4*)(xr + 4 * lane + 256 * j); }
        if (part != nullptr && m >= MP) {
            add_slabs(v, part, ns, m - MP, lane);
#pragma unroll
            for (int j = 0; j < 8; ++j) *(f32x4*)(xw + (size_t)m * DM + 4 * lane + 256 * j) = v[j];
        }
#pragma unroll
        for (int j = 0; j < 8; ++j) { s += (v[j].x * v[j].x + v[j].y * v[j].y) + (v[j].z * v[j].z + v[j].w * v[j].w);
            *(u32x2*)(XB + (size_t)m * DM + 4 * lane + 256 * j) = (u32x2){cvt_pk_bf16(v[j].x, v[j].y), cvt_pk_bf16(v[j].z, v[j].w)}; }
        s = wave_sum(s);
        if (lane == 0) RSS[m] = s;
    }
}

__device__ __forceinline__ void ph_xprep_samp(float* X, bf16_t* XB, float* RSS, const float* part, int ns, LAS float* red) {
    int tid_ = threadIdx.x; asm volatile("" : "+v"(tid_)); const int lane = tid_ & 63, wave = __builtin_amdgcn_readfirstlane(tid_ >> 6);
    __syncthreads();
    for (int rp = blockIdx.x; rp < MS / 2; rp += gridDim.x) {
        const int ms = 2 * rp + (wave >> 2), q = wave & 3, m = MP + ms; const size_t off = (size_t)m * DM + q * 512 + 4 * lane;
        f32x4 v[2] = {*(const f32x4*)(X + off), *(const f32x4*)(X + off + 256)};
        const float* pr = part + (size_t)ms * DM + q * 512 + 4 * lane;
        if (ns == 16) { f32x4 t[16][2];
#pragma unroll
            for (int sl = 0; sl < 16; ++sl) { t[sl][0] = *(const f32x4*)(pr + (size_t)sl * MS * DM); t[sl][1] = *(const f32x4*)(pr + (size_t)sl * MS * DM + 256); }
            __builtin_amdgcn_sched_barrier(0);
#pragma unroll
            for (int sl = 0; sl < 16; sl += 4) { v[0] += (t[sl][0] + t[sl + 1][0]) + (t[sl + 2][0] + t[sl + 3][0]); v[1] += (t[sl][1] + t[sl + 1][1]) + (t[sl + 2][1] + t[sl + 3][1]); } }
        else { f32x4 t[8][2];
#pragma unroll
            for (int sl = 0; sl < 8; ++sl) { t[sl][0] = *(const f32x4*)(pr + (size_t)sl * MS * DM); t[sl][1] = *(const f32x4*)(pr + (size_t)sl * MS * DM + 256); }
            __builtin_amdgcn_sched_barrier(0);
#pragma unroll
            for (int sl = 0; sl < 8; sl += 4) { v[0] += (t[sl][0] + t[sl + 1][0]) + (t[sl + 2][0] + t[sl + 3][0]); v[1] += (t[sl][1] + t[sl + 1][1]) + (t[sl + 2][1] + t[sl + 3][1]); } }
        float s = 0.f;
#pragma unroll
        for (int j = 0; j < 2; ++j) { *(f32x4*)(X + off + 256 * j) = v[j];
            *(u32x2*)(XB + off + 256 * j) = (u32x2){cvt_pk_bf16(v[j].x, v[j].y), cvt_pk_bf16(v[j].z, v[j].w)};
            s += (v[j].x * v[j].x + v[j].y * v[j].y) + (v[j].z * v[j].z + v[j].w * v[j].w); }
        s = wave_sum(s);
        if (lane == 0) red[wave] = s;
        __syncthreads();
        if ((wave & 3) == 0 && lane == 0) RSS[m] = (red[wave] + red[wave + 1]) + (red[wave + 2] + red[wave + 3]);
        __syncthreads();
    }
}
__device__ __forceinline__ void zero_f32(float* p, int n) {
    int tid_ = threadIdx.x; asm volatile("" : "+v"(tid_));
    for (int e = blockIdx.x * NTHREADS + tid_; e < n; e += gridDim.x * NTHREADS) p[e] = 0.f;
}
template <bool OUT_F32>
__device__ __forceinline__ void ph_rmsnorm(const float* xp, const float* xs_adj, const float* gain, bf16_t* H, float* outf, int NGW, const float* part = nullptr, int ns = 0, float* xw = nullptr, const bf16_t* xb = nullptr) {
    int tid_ = threadIdx.x; asm volatile("" : "+v"(tid_)); const int lane = tid_ & 63, wave = __builtin_amdgcn_readfirstlane(tid_ >> 6), gw = blockIdx.x * NWAVES + wave; (void)wave;
    f32x4 g[8];
#pragma unroll
    for (int j = 0; j < 8; ++j) g[j] = *(const f32x4*)(gain + 4 * lane + 256 * j);
    u32x2 wn[8];
    if (xb != nullptr && gw < MP) {
#pragma unroll
        for (int j = 0; j < 8; ++j) wn[j] = *(const u32x2*)(xb + (size_t)gw * DM + 4 * lane + 256 * j); }
    for (int m = gw; m < M; m += NGW) {
        const float* xr = ((m < MP) ? xp : xs_adj) + (size_t)m * DM;
        f32x4 v[8]; float s = 0.f;
        if (xb != nullptr && m < MP) {
#pragma unroll
            for (int j = 0; j < 8; ++j) v[j] = (f32x4){bf_lo(wn[j].x), bf_hi(wn[j].x), bf_lo(wn[j].y), bf_hi(wn[j].y)}; }
        else {
#pragma unroll
            for (int j = 0; j < 8; ++j) v[j] = *(const f32x4*)(xr + 4 * lane + 256 * j); }
        if (xb != nullptr && m + NGW < MP) {
#pragma unroll
            for (int j = 0; j < 8; ++j) wn[j] = *(const u32x2*)(xb + (size_t)(m + NGW) * DM + 4 * lane + 256 * j); }
        if (part != nullptr && m >= MP) {
            add_slabs(v, part, ns, m - MP, lane);
#pragma unroll
            for (int j = 0; j < 8; ++j) *(f32x4*)(xw + (size_t)m * DM + 4 * lane + 256 * j) = v[j];
        }
#pragma unroll
        for (int j = 0; j < 8; ++j) { s += (v[j].x * v[j].x + v[j].y * v[j].y) + (v[j].z * v[j].z + v[j].w * v[j].w); }
        const float rstd = 1.0f / sqrtf(wave_sum(s) * (1.0f / DM) + EPS);
#pragma unroll
        for (int j = 0; j < 8; ++j) {
            const f32x4 y = v[j] * rstd * g[j];
            if (OUT_F32) *(f32x4*)(outf + (size_t)m * DM + 4 * lane + 256 * j) = y;
            else *(u32x2*)(H + (size_t)m * DM + 4 * lane + 256 * j) = (u32x2){cvt_pk_bf16(y.x, y.y), cvt_pk_bf16(y.z, y.w)};
        }
    }
}

__device__ __forceinline__ void ph_mla_post(const Ctx& a, int i, int NGW) {
    int tid_ = threadIdx.x; asm volatile("" : "+v"(tid_)); const int lane = tid_ & 63, wave = __builtin_amdgcn_readfirstlane(tid_ >> 6), gw = blockIdx.x * NWAVES + wave; (void)wave;
    const bf16_t* INB = (const bf16_t*)(a.ws + WS_ACT + A_INAB);
    bf16_t* CQN = (bf16_t*)(a.ws + WS_ACT + A_CQN); bf16_t* ACKV = (bf16_t*)(a.ws + WS_ACT + A_ACKV); bf16_t* AKR = (bf16_t*)(a.ws + WS_ACT + A_AKR);
    const f32x2* rope = (const f32x2*)(a.ws + WS_ROPE);
    const float* qg = arg_in(11) + i * QL; const float* kg = arg_in(12) + i * KVL;
    f32x4 qg0 = *(const f32x4*)(qg + 8 * lane), qg1 = *(const f32x4*)(qg + 8 * lane + 4), kg0 = *(const f32x4*)(kg + 4 * lane);
    struct RowIn { u32x4 cq; u32x2 ck; unsigned short x1h, x2h; f32x2 cs; };
    auto load_row = [&](int m, RowIn& o) { const bf16_t* r = INB + (size_t)m * INABP;
        o.cq = *(const u32x4*)(r + C_CQ + 8 * lane); o.ck = *(const u32x2*)(r + C_CKV + 4 * lane);
        o.x1h = r[C_KR + (lane & 31)]; o.x2h = r[C_KR + 32 + (lane & 31)]; o.cs = rope[(size_t)row_pos(m) * 128 + 4 * (lane & 31)]; };
    RowIn nx; if (gw < M) load_row(gw, nx);
    for (int m = gw; m < M + DB * PAST; m += NGW) {
        if (m < M) {
            const RowIn cu = nx; if (m + NGW < M) load_row(m + NGW, nx);
            const u32x4 cq = cu.cq; const u32x2 ck = cu.ck; const unsigned short x1h = cu.x1h, x2h = cu.x2h; const f32x2 cs = cu.cs;
            const int kr = row_key(m);
            float q[8] = {bf_lo(cq.x), bf_hi(cq.x), bf_lo(cq.y), bf_hi(cq.y), bf_lo(cq.z), bf_hi(cq.z), bf_lo(cq.w), bf_hi(cq.w)};
            float k[4] = {bf_lo(ck.x), bf_hi(ck.x), bf_lo(ck.y), bf_hi(ck.y)};
            float sq = 0.f, sk = 0.f;
#pragma unroll
            for (int j = 0; j < 8; ++j) sq += q[j] * q[j];
#pragma unroll
            for (int j = 0; j < 4; ++j) sk += k[j] * k[j];
            const float rq = 1.0f / sqrtf(wave_sum(sq) * (1.0f / QL) + EPS), rk = 1.0f / sqrtf(wave_sum(sk) * (1.0f / KVL) + EPS);
            u32x4 oq; oq.x = cvt_pk_bf16(q[0] * rq * qg0.x, q[1] * rq * qg0.y); oq.y = cvt_pk_bf16(q[2] * rq * qg0.z, q[3] * rq * qg0.w);
            oq.z = cvt_pk_bf16(q[4] * rq * qg1.x, q[5] * rq * qg1.y); oq.w = cvt_pk_bf16(q[6] * rq * qg1.z, q[7] * rq * qg1.w);
            *(u32x4*)(CQN + (size_t)m * QL + 8 * lane) = oq;
            const f32x4 ko = (f32x4){k[0] * rk * kg0.x, k[1] * rk * kg0.y, k[2] * rk * kg0.z, k[3] * rk * kg0.w};
            float* ckv_out = (m < MP) ? a.out + O_CKV_P + ((size_t)i * MP + m) * KVL : a.out + O_CKV_S + ((size_t)i * MS + (m - MP)) * KVL;
            *(f32x4*)(ckv_out + 4 * lane) = ko;
            *(u32x2*)(ACKV + (size_t)kr * KVL + 4 * lane) = (u32x2){cvt_pk_bf16(ko.x, ko.y), cvt_pk_bf16(ko.z, ko.w)};
            if (lane < 32) {
                const float x1 = bf2f(x1h), x2 = bf2f(x2h);
                const float o1 = x1 * cs.x - x2 * cs.y, o2 = x1 * cs.y + x2 * cs.x;
                float* kr_out = (m < MP) ? a.out + O_KR_P + ((size_t)i * MP + m) * ROPE : a.out + O_KR_S + ((size_t)i * MS + (m - MP)) * ROPE;
                kr_out[lane] = o1; kr_out[32 + lane] = o2;
                *(unsigned*)(AKR + (size_t)kr * ROPE + 2 * lane) = cvt_pk_bf16(o1, o2);
            }
        } else {
            const int idx = m - M, b = idx >> 10, p = idx & (PAST - 1), kr = MP + b * KEYS_S + p;
            const f32x4 v = *(const f32x4*)(arg_in(2) + (((size_t)i * DB + b) * PAST + p) * KVL + 4 * lane);
            *(u32x2*)(ACKV + (size_t)kr * KVL + 4 * lane) = (u32x2){cvt_pk_bf16(v.x, v.y), cvt_pk_bf16(v.z, v.w)};
            if (lane < 32) { const float* kp = arg_in(3) + (((size_t)i * DB + b) * PAST + p) * ROPE;
                *(unsigned*)(AKR + (size_t)kr * ROPE + 2 * lane) = cvt_pk_bf16(kp[lane], kp[32 + lane]); }
        }
    }
}

__device__ __forceinline__ void ph_q_rope(const Ctx& a, int NGW, bool st = true) {
    int tid_ = threadIdx.x; asm volatile("" : "+v"(tid_)); const int lane = tid_ & 63, wave = __builtin_amdgcn_readfirstlane(tid_ >> 6), gw = blockIdx.x * NWAVES + wave; (void)wave;
    bf16_t* Q = (bf16_t*)(a.ws + WS_ACT + A_Q); const f32x2* rope = (const f32x2*)(a.ws + WS_ROPE);
    const int h = lane >> 3, j0 = 4 * (lane & 7);
    for (int m = gw; m < M; m += NGW) {
        bf16_t* p1 = Q + (size_t)m * QW + h * QHD + 128 + j0; bf16_t* p2 = p1 + 32;
        const u32x2 a1 = *(const u32x2*)p1, a2 = *(const u32x2*)p2;
        const float x1[4] = {bf_lo(a1.x), bf_hi(a1.x), bf_lo(a1.y), bf_hi(a1.y)}, x2[4] = {bf_lo(a2.x), bf_hi(a2.x), bf_lo(a2.y), bf_hi(a2.y)};
        const f32x2* cs = rope + (size_t)row_pos(m) * 128 + 4 * j0;
        float o1[4], o2[4];
#pragma unroll
        for (int k = 0; k < 4; ++k) { const f32x2 c = cs[4 * k]; o1[k] = x1[k] * c.x - x2[k] * c.y; o2[k] = x1[k] * c.y + x2[k] * c.x; }
        if (st) { *(u32x2*)p1 = (u32x2){cvt_pk_bf16(o1[0], o1[1]), cvt_pk_bf16(o1[2], o1[3])};
        *(u32x2*)p2 = (u32x2){cvt_pk_bf16(o2[0], o2[1]), cvt_pk_bf16(o2[2], o2[3])}; }
        else if (o1[0] == 1.2345e30f) p1[0] = 0;
    }
}

__device__ __forceinline__ void ph_qk_rope(const Ctx& a, int NGW, bool st = true) {
    int tid_ = threadIdx.x; asm volatile("" : "+v"(tid_)); const int lane = tid_ & 63, wave = __builtin_amdgcn_readfirstlane(tid_ >> 6), gw = blockIdx.x * NWAVES + wave; (void)wave;
    bf16_t* X = (bf16_t*)(a.ws + WS_ACT + A_INC); const f32x2* rope = (const f32x2*)(a.ws + WS_ROPE);
    for (int m = gw; m < M; m += NGW) {
        const f32x2* cs0 = rope + (size_t)row_pos(m) * 128;
#pragma unroll
        for (int it = 0; it < 4; ++it) {
            const int e = it * 64 + lane, th = e >> 4, j0 = (e & 15) * 8;
            bf16_t* p1 = X + (size_t)m * INC + th * 256 + j0; bf16_t* p2 = p1 + 128;
            const u32x4 a1 = *(const u32x4*)p1, a2 = *(const u32x4*)p2;
            const float x1[8] = {bf_lo(a1.x), bf_hi(a1.x), bf_lo(a1.y), bf_hi(a1.y), bf_lo(a1.z), bf_hi(a1.z), bf_lo(a1.w), bf_hi(a1.w)};
            const float x2[8] = {bf_lo(a2.x), bf_hi(a2.x), bf_lo(a2.y), bf_hi(a2.y), bf_lo(a2.z), bf_hi(a2.z), bf_lo(a2.w), bf_hi(a2.w)};
            const float sc = (th >= 8) ? 0.0625f : 1.0f;
            float o1[8], o2[8];
#pragma unroll
            for (int k = 0; k < 4; ++k) { const f32x4 c2 = *(const f32x4*)(cs0 + j0 + 2 * k);
                o1[2 * k] = (x1[2 * k] * c2.x - x2[2 * k] * c2.y) * sc; o2[2 * k] = (x1[2 * k] * c2.y + x2[2 * k] * c2.x) * sc;
                o1[2 * k + 1] = (x1[2 * k + 1] * c2.z - x2[2 * k + 1] * c2.w) * sc; o2[2 * k + 1] = (x1[2 * k + 1] * c2.w + x2[2 * k + 1] * c2.z) * sc; }
            if (st) { *(u32x4*)p1 = (u32x4){cvt_pk_bf16(o1[0], o1[1]), cvt_pk_bf16(o1[2], o1[3]), cvt_pk_bf16(o1[4], o1[5]), cvt_pk_bf16(o1[6], o1[7])};
            *(u32x4*)p2 = (u32x4){cvt_pk_bf16(o2[0], o2[1]), cvt_pk_bf16(o2[2], o2[3]), cvt_pk_bf16(o2[4], o2[5]), cvt_pk_bf16(o2[6], o2[7])}; }
            else if (o1[0] == 1.2345e30f) p1[0] = 0;
        }
    }
}

__device__ __forceinline__ void ph_gn_gate(const Ctx& a, int i, int NGW) {
    int tid_ = threadIdx.x; asm volatile("" : "+v"(tid_)); const int lane = tid_ & 63, wave = __builtin_amdgcn_readfirstlane(tid_ >> 6), gw = blockIdx.x * NWAVES + wave;
    bf16_t* X = (bf16_t*)(a.ws + WS_ACT + A_INC);
    const float* gnb = arg_in(27) + (size_t)i * RH * RDV + 8 * lane;
    const int h0 = gw & 7; const f32x4 g0 = *(const f32x4*)(gnb + h0 * RDV), g1 = *(const f32x4*)(gnb + h0 * RDV + 4); const float gg[8] = {g0.x, g0.y, g0.z, g0.w, g1.x, g1.y, g1.z, g1.w};
    constexpr int U = 4;
    u32x4 no[U], ng[U];
    auto load_round = [&](int it0) {
#pragma unroll
        for (int u = 0; u < U; ++u) { const int it = it0 + u * NGW; const int itc = (it < M * RH) ? it : it0; const int m = itc >> 3, h = itc & 7;
            const bf16_t* po = X + (size_t)m * INC + C_RV + h * RDV + 8 * lane; no[u] = *(const u32x4*)po; ng[u] = *(const u32x4*)(po + (C_RG - C_RV)); } };
    if (gw < M * RH) load_round(gw);
    for (int it0 = gw; it0 < M * RH; it0 += U * NGW) {
        u32x4 ao[U], ag[U]; bool ok[U];
#pragma unroll
        for (int u = 0; u < U; ++u) { ao[u] = no[u]; ag[u] = ng[u]; ok[u] = it0 + u * NGW < M * RH; }
        if (it0 + U * NGW < M * RH) load_round(it0 + U * NGW);
#pragma unroll
        for (int u = 0; u < U; ++u) { const int it = it0 + u * NGW; const int itc = ok[u] ? it : it0; const int m = itc >> 3, h = itc & 7;
            const float o[8] = {bf_lo(ao[u].x), bf_hi(ao[u].x), bf_lo(ao[u].y), bf_hi(ao[u].y), bf_lo(ao[u].z), bf_hi(ao[u].z), bf_lo(ao[u].w), bf_hi(ao[u].w)};
            const float g[8] = {bf_lo(ag[u].x), bf_hi(ag[u].x), bf_lo(ag[u].y), bf_hi(ag[u].y), bf_lo(ag[u].z), bf_hi(ag[u].z), bf_lo(ag[u].w), bf_hi(ag[u].w)};
            float s = 0.f;
#pragma unroll
            for (int k = 0; k < 8; ++k) s += o[k];
            const float mu = wave_sum(s) * (1.0f / RDV); float q = 0.f;
#pragma unroll
            for (int k = 0; k < 8; ++k) { const float d = o[k] - mu; q += d * d; }
            const float rstd = 1.0f / sqrtf(wave_sum(q) * (1.0f / RDV) + GN_EPS);
            float r[8];
#pragma unroll
            for (int k = 0; k < 8; ++k) r[k] = (o[k] - mu) * rstd * gg[k] * (g[k] / (1.0f + __expf(-g[k])));
            if (ok[u]) *(u32x4*)(X + (size_t)m * INC + C_RV + h * RDV + 8 * lane) = (u32x4){cvt_pk_bf16(r[0], r[1]), cvt_pk_bf16(r[2], r[3]), cvt_pk_bf16(r[4], r[5]), cvt_pk_bf16(r[6], r[7])};
        }
    }
}

constexpr int S5_PITCH = 132;
constexpr int S5_WAVE_BYTES = 32 * S5_PITCH * 4;
static_assert(NWAVES * S5_WAVE_BYTES <= LDS_MAIN, "S5 LDS");
__device__ __forceinline__ float gelu_tanh(float x) {
    const float u = 0.7978845608028654f * (x + 0.044715f * x * x * x);
    const float e = __expf(2.0f * u);
    const float t = 1.0f - 2.0f / (e + 1.0f);
    return 0.5f * x * (1.0f + t);
}
template <int PASS>
__device__ __forceinline__ void ph_s5(const Ctx& a, int i, LAS unsigned char* lds, int NGW, size_t zoff = A_Z) {
    int tid_ = threadIdx.x; asm volatile("" : "+v"(tid_)); const int lane = tid_ & 63, wave = __builtin_amdgcn_readfirstlane(tid_ >> 6), gw = blockIdx.x * NWAVES + wave;
    const unsigned char* tab = a.ws + WS_S5TAB + (size_t)i * S5TAB_STRIDE;
    const f32x4* atab = (const f32x4*)(tab + S5T_A); const bf16_t* bbt = (const bf16_t*)(tab + S5T_B); const bf16_t* cmt = (const bf16_t*)(tab + S5T_C);
    const bf16_t* INB = (const bf16_t*)(a.ws + WS_ACT + A_INAB); bf16_t* Z = (bf16_t*)(a.ws + WS_ACT + zoff);
    float* car = (float*)(a.ws + WS_S5CAR);
    const float* in_sre = arg_in(4); const float* in_sim = arg_in(5); const float* in_d = arg_in(22);
    LAS float* T = (LAS float*)(lds + wave * S5_WAVE_BYTES);
    const int r32 = lane & 31, hi = lane >> 5, l15 = lane & 15, kg = lane >> 4;
    constexpr int NU_P = NB * (S5G / 4) * (SEQ / 64), NU_S = DB * (S5G / 4);
    const int nunits = (PASS == 0) ? NU_P : NU_P + NU_S;
    struct Ops { bf16x8 ua[2], bb[4], cb[4]; f32x4 av; float sre, sim; f32x4 dskv; u32x2 uvq[2][2]; int b, g, c, row0; bool samp; };
    auto load_ops = [&](int u4, Ops& o) {
        const int u = u4 >> 2, gi = u4 & 3;
        int b, g, c, row0; bool samp = false;
        if (u < NU_P) { c = u & 127; g = ((u >> 7) & 15) * 4 + gi; b = u >> 11; row0 = b * SEQ + c * 64; }
        else { const int v = u - NU_P; samp = true; c = 0; g = (v & 15) * 4 + gi; b = v >> 4; row0 = MP + b * DS; }
        o.b = b; o.g = g; o.c = c; o.row0 = row0; o.samp = samp;
#pragma unroll
        for (int tt = 0; tt < 2; ++tt) o.ua[tt] = *(const bf16x8*)(INB + (size_t)(row0 + tt * 32 + r32) * INABP + C_U + 16 * g + 8 * hi);
#pragma unroll
        for (int nt = 0; nt < 4; ++nt) o.bb[nt] = *(const bf16x8*)(bbt + ((size_t)g * 128 + 32 * nt + r32) * 16 + 8 * hi);
        o.av = atab[g * S5N + lane];
        o.sre = 0.f; o.sim = 0.f; o.dskv = (f32x4){0.f, 0.f, 0.f, 0.f};
        if (PASS == 1) {
            const float* pre = samp ? in_sre + (((size_t)i * DB + b) * S5G + g) * S5N : car + (((size_t)b * S5G + g) * 128 + c) * 128;
            const float* pim = samp ? in_sim + (((size_t)i * DB + b) * S5G + g) * S5N : car + (((size_t)b * S5G + g) * 128 + c) * 128 + 64;
            o.sre = pre[lane]; o.sim = pim[lane];
#pragma unroll
            for (int ks = 0; ks < 4; ++ks) o.cb[ks] = *(const bf16x8*)(cmt + ((size_t)g * 16 + l15) * 128 + 32 * ks + 8 * kg);
            o.dskv = *(const f32x4*)(in_d + ((size_t)i * S5G + g) * S5P + 4 * kg);
#pragma unroll
            for (int tt = 0; tt < 2; ++tt)
#pragma unroll
                for (int t16 = 0; t16 < 2; ++t16)
                    o.uvq[tt][t16] = *(const u32x2*)(INB + (size_t)(row0 + tt * 32 + t16 * 16 + l15) * INABP + C_U + 16 * g + 4 * kg);
        }
    };
    int u4 = gw * 4;
    if (u4 >= nunits * 4) return;
    Ops nx; load_ops(u4, nx);
    for (;;) {
        const Ops cu = nx;
        const int u4n = ((u4 & 3) == 3) ? u4 - 3 + NGW * 4 : u4 + 1; const bool has_next = u4n < nunits * 4;
        if (has_next) load_ops(u4n, nx);
        const int b = cu.b, g = cu.g, c = cu.c, row0 = cu.row0; const bool samp = cu.samp;
        const bf16x8 ua[2] = {cu.ua[0], cu.ua[1]}; const bf16x8 bb[4] = {cu.bb[0], cu.bb[1], cu.bb[2], cu.bb[3]}; const bf16x8 cb[4] = {cu.cb[0], cu.cb[1], cu.cb[2], cu.cb[3]};
        const f32x4 av = cu.av; float sre = cu.sre, sim = cu.sim; const f32x4 dskv = cu.dskv;
#pragma unroll
        for (int tt = 0; tt < 2; ++tt) {
#pragma unroll
            for (int nt = 0; nt < 4; ++nt) {
                f32x16 acc = {}; acc = __builtin_amdgcn_mfma_f32_32x32x16_bf16(bb[nt], ua[tt], acc, 0, 0, 0);
#pragma unroll
                for (int q = 0; q < 4; ++q) *(LAS f32x4*)(T + r32 * S5_PITCH + 32 * nt + 8 * q + 4 * hi) = (f32x4){acc[4 * q], acc[4 * q + 1], acc[4 * q + 2], acc[4 * q + 3]};
            }
            LDS_WAIT(); asm volatile("" ::: "memory");
#pragma unroll 8
            for (int t = 0; t < 32; ++t) {
                const float bre = T[t * S5_PITCH + lane], bim = T[t * S5_PITCH + 64 + lane];

                float nre = __builtin_fmaf(av.x, sre, bre); asm volatile("" : "+v"(nre));
                float nim = __builtin_fmaf(av.x, sim, bim); asm volatile("" : "+v"(nim));
                nre = __builtin_fmaf(-av.y, sim, nre); asm volatile("" : "+v"(nre));
                nim = __builtin_fmaf(av.y, sre, nim); asm volatile("" : "+v"(nim));

                sre = nre; sim = nim;
                if (PASS == 1) { T[t * S5_PITCH + lane] = nre; T[t * S5_PITCH + 64 + lane] = nim; }
            }
            if (PASS == 1) {
                LDS_WAIT(); asm volatile("" ::: "memory");
#pragma unroll
                for (int t16 = 0; t16 < 2; ++t16) {
                    f32x4 y = {0.f, 0.f, 0.f, 0.f};
#pragma unroll
                    for (int ks = 0; ks < 4; ++ks) {
                        const LAS float* sp = T + (t16 * 16 + l15) * S5_PITCH + 32 * ks + 8 * kg;
                        const f32x4 s0 = *(const LAS f32x4*)sp, s1 = *(const LAS f32x4*)(sp + 4);
                        u32x4 w = {cvt_pk_bf16(s0.x, s0.y), cvt_pk_bf16(s0.z, s0.w), cvt_pk_bf16(s1.x, s1.y), cvt_pk_bf16(s1.z, s1.w)};
                        y = __builtin_amdgcn_mfma_f32_16x16x32_bf16(cb[ks], __builtin_bit_cast(bf16x8, w), y, 0, 0, 0);
                    }
                    { const u32x2 q = cu.uvq[tt][t16]; const float uvf[4] = {bf_lo(q.x), bf_hi(q.x), bf_lo(q.y), bf_hi(q.y)}; float z[4];
#pragma unroll
                        for (int r = 0; r < 4; ++r) z[r] = gelu_tanh(y[r] + dskv[r] * uvf[r]);
                        *(u32x2*)(Z + (size_t)(row0 + tt * 32 + t16 * 16 + l15) * S5W + 16 * g + 4 * kg) = (u32x2){cvt_pk_bf16(z[0], z[1]), cvt_pk_bf16(z[2], z[3])}; }
                }
                LDS_WAIT(); asm volatile("" ::: "memory");
            }
        }
        if (PASS == 0) { float* cp = car + (((size_t)b * S5G + g) * 128 + c) * 128;
            cp[lane] = sre; cp[64 + lane] = sim; }
        else if (samp || c == 127) {
            float* ore = samp ? a.out + O_S5RE_S + (((size_t)i * DB + b) * S5G + g) * S5N : a.out + O_S5RE_P + (((size_t)i * NB + b) * S5G + g) * S5N;
            float* oim = samp ? a.out + O_S5IM_S + (((size_t)i * DB + b) * S5G + g) * S5N : a.out + O_S5IM_P + (((size_t)i * NB + b) * S5G + g) * S5N;
            ore[lane] = sre; oim[lane] = sim;
        }
        if (!has_next) break;
        u4 = u4n;
    }
}
__device__ __forceinline__ void ph_s5_carry(const Ctx& a, int i, int NGW) {
    int tid_ = threadIdx.x; asm volatile("" : "+v"(tid_)); const int lane = tid_ & 63, wave = __builtin_amdgcn_readfirstlane(tid_ >> 6), gw = blockIdx.x * NWAVES + wave; (void)wave;
    const f32x4* atab = (const f32x4*)(a.ws + WS_S5TAB + (size_t)i * S5TAB_STRIDE + S5T_A);
    float* car = (float*)(a.ws + WS_S5CAR);
    for (int u = gw; u < NB * S5G; u += NGW) {
        const int g = u & 63; const f32x4 av = atab[g * S5N + lane];
        float* cp = car + (size_t)u * 128 * 128;
        float cre = 0.f, cim = 0.f;
        float nr_[16], ni_[16];
#pragma unroll
        for (int k = 0; k < 16; ++k) { nr_[k] = cp[k * 128 + lane]; ni_[k] = cp[k * 128 + 64 + lane]; }
#pragma unroll 1
        for (int c0 = 0; c0 < 128; c0 += 16) {
            float er[16], ei[16];
#pragma unroll
            for (int k = 0; k < 16; ++k) { er[k] = nr_[k]; ei[k] = ni_[k]; }
            if (c0 + 16 < 128) {
#pragma unroll
                for (int k = 0; k < 16; ++k) { nr_[k] = cp[(c0 + 16 + k) * 128 + lane]; ni_[k] = cp[(c0 + 16 + k) * 128 + 64 + lane]; } }
#pragma unroll
            for (int k = 0; k < 16; ++k) {
                cp[(c0 + k) * 128 + lane] = cre; cp[(c0 + k) * 128 + 64 + lane] = cim;
                float nr = __builtin_fmaf(av.z, cre, er[k]); asm volatile("" : "+v"(nr));
                float ni = __builtin_fmaf(av.z, cim, ei[k]); asm volatile("" : "+v"(ni));
                nr = __builtin_fmaf(-av.w, cim, nr); asm volatile("" : "+v"(nr));
                ni = __builtin_fmaf(av.w, cre, ni); asm volatile("" : "+v"(ni));
                cre = nr; cim = ni;
            }
        }
    }
}

namespace att {
constexpr int KROWB = 384, KBYTES = 64 * KROWB, VBYTES = 16384, SLOT = KBYTES + VBYTES, NSLOT = 3, WS_OFF = NSLOT * SLOT;
static_assert(WS_OFF + NWAVES * 256 <= LDS_MAIN, "attention LDS");
constexpr float SCALE = 0.07216878364870322f, THR = 8.f;
#define ATT_KSWZ(row, colB) ((row) * att::KROWB + ((colB) ^ (((row) & 7) << 4)))
#define SBAR() __builtin_amdgcn_sched_barrier(0)
__device__ __forceinline__ int crow(int r, int hi) { return (r & 3) + 8 * (r >> 2) + 4 * hi; }

__device__ __forceinline__ void partialSM(f32x16& p0, f32x16& p1, float& m_reg, float& mn, float& alpha) {
    constexpr float C = SCALE * 1.4426950408889634f;
    float pmax = p0[0];
#pragma unroll
    for (int r = 1; r < 16; ++r) pmax = fmaxf(pmax, p0[r]);
#pragma unroll
    for (int r = 0; r < 16; ++r) pmax = fmaxf(pmax, p1[r]);
    { auto rr = __builtin_amdgcn_permlane32_swap(__float_as_uint(pmax), __float_as_uint(pmax), false, false); pmax = fmaxf(__uint_as_float(rr[0]), __uint_as_float(rr[1])); }
    if (__builtin_expect(__all(pmax - m_reg <= THR / SCALE), 1)) { mn = m_reg; alpha = 1.f; }
    else { mn = fmaxf(m_reg, pmax); alpha = __builtin_amdgcn_exp2f((m_reg - mn) * C); m_reg = mn; }
    const float mnC = -mn * C;
#pragma unroll
    for (int r = 0; r < 16; ++r) { p0[r] = __builtin_amdgcn_exp2f(fmaf(p0[r], C, mnC)); p1[r] = __builtin_amdgcn_exp2f(fmaf(p1[r], C, mnC)); }
}
__device__ __forceinline__ void finishSM(const f32x16& p0, const f32x16& p1, float alpha, float& l_reg, bf16x8& pa0, bf16x8& pa1, bf16x8& pa2, bf16x8& pa3) {
    float ps = 0.f;
#pragma unroll
    for (int r = 0; r < 16; ++r) ps += p0[r];
#pragma unroll
    for (int r = 0; r < 16; ++r) ps += p1[r];
    { auto rr = __builtin_amdgcn_permlane32_swap(__float_as_uint(ps), __float_as_uint(ps), false, false); ps = __uint_as_float(rr[0]) + __uint_as_float(rr[1]); }
    l_reg = l_reg * alpha + ps;
#define ATT_PK4(P, BASE, OUT) do { unsigned a0 = cvt_pk_bf16(P[BASE + 0], P[BASE + 1]), a1 = cvt_pk_bf16(P[BASE + 2], P[BASE + 3]);   \
    unsigned b0 = cvt_pk_bf16(P[BASE + 4], P[BASE + 5]), b1 = cvt_pk_bf16(P[BASE + 6], P[BASE + 7]);                              \
    auto r0 = __builtin_amdgcn_permlane32_swap(a0, b0, false, false); auto r1 = __builtin_amdgcn_permlane32_swap(a1, b1, false, false); \
    u32x4 w = {r0[0], r1[0], r0[1], r1[1]}; OUT = __builtin_bit_cast(bf16x8, w); } while (0)
    ATT_PK4(p0, 0, pa0); ATT_PK4(p0, 8, pa1); ATT_PK4(p1, 0, pa2); ATT_PK4(p1, 8, pa3);
#undef ATT_PK4
}
__device__ __forceinline__ int v_rd_base(int lane) { return ((lane & 3) << 3) | (((lane >> 2) & 3) << 6) | (((lane >> 4) & 1) << 5) | (((lane >> 5) & 1) << 8); }
constexpr int v_rd_off(int d0, int ks, int half) { return d0 * 512 + ks * 4096 + half * 2048; }
__device__ __forceinline__ void glds16(const void* gsrc, unsigned lds_dst) { unsigned keep;
    asm volatile("s_mov_b32 %0, m0\n\ts_mov_b32 m0, %2\n\ts_nop 0\n\tglobal_load_lds_dwordx4 %1, off\n\ts_mov_b32 m0, %0" : "=&s"(keep) : "v"(gsrc), "s"(lds_dst) : "memory"); }
template <int OFF> __device__ __forceinline__ s16x4 tr_read(int vb) { s16x4 r; asm volatile("ds_read_b64_tr_b16 %0, %1 offset:%2" : "=&v"(r) : "v"(vb), "i"(OFF) : "memory"); return r; }
template <int D0> __device__ __forceinline__ void pv_one(f32x16& od, int vb, bf16x8 pa0, bf16x8 pa1, bf16x8 pa2, bf16x8 pa3) {
    const s16x4 l0 = tr_read<v_rd_off(D0, 0, 0)>(vb), h0 = tr_read<v_rd_off(D0, 0, 1)>(vb), l1 = tr_read<v_rd_off(D0, 1, 0)>(vb), h1 = tr_read<v_rd_off(D0, 1, 1)>(vb);
    const s16x4 l2 = tr_read<v_rd_off(D0, 2, 0)>(vb), h2 = tr_read<v_rd_off(D0, 2, 1)>(vb), l3 = tr_read<v_rd_off(D0, 3, 0)>(vb), h3 = tr_read<v_rd_off(D0, 3, 1)>(vb);
    asm volatile("s_waitcnt lgkmcnt(0)" ::: "memory"); SBAR();
#define ATT_PK(L, H) (bf16x8){L[0], L[1], L[2], L[3], H[0], H[1], H[2], H[3]}
    od = __builtin_amdgcn_mfma_f32_32x32x16_bf16(pa0, ATT_PK(l0, h0), od, 0, 0, 0);
    od = __builtin_amdgcn_mfma_f32_32x32x16_bf16(pa1, ATT_PK(l1, h1), od, 0, 0, 0);
    od = __builtin_amdgcn_mfma_f32_32x32x16_bf16(pa2, ATT_PK(l2, h2), od, 0, 0, 0);
    od = __builtin_amdgcn_mfma_f32_32x32x16_bf16(pa3, ATT_PK(l3, h3), od, 0, 0, 0);
#undef ATT_PK
}

__device__ __forceinline__ void attn_phase(const Ctx& a, LAS unsigned char* lds, int vcu, int G) {
    int tid_ = threadIdx.x; asm volatile("" : "+v"(tid_));
    const int tid = tid_, lane = tid & 63, r32 = lane & 31, hi = lane >> 5; const int wid = __builtin_amdgcn_readfirstlane(tid >> 6);
    const bf16_t* Q = (const bf16_t*)(a.ws + WS_ACT + A_Q); const bf16_t* KV = (const bf16_t*)(a.ws + WS_ACT + A_KV); const bf16_t* AKR = (const bf16_t*)(a.ws + WS_ACT + A_AKR);
    bf16_t* OUT = (bf16_t*)(a.ws + WS_ACT + A_MIX);
    LAS float* wsf = (LAS float*)(lds + WS_OFF) + wid * 64; LAS float* li_l = wsf; LAS float* al_l = wsf + 32;
    const int ldsbase = (int)(unsigned)(size_t)lds;
    const int vbl = v_rd_base(lane);
    int krow[3], kcol[3], vkey[2], vcol[2];
#pragma unroll
    for (int ii = 0; ii < 3; ++ii) { const int s = (wid + 8 * ii) * 64 + lane, row = s / 24, chp = s - row * 24, ch = (chp & ~7) | ((chp ^ row) & 7); krow[ii] = row; kcol[ii] = 8 * ch; }
#pragma unroll
    for (int ii = 0; ii < 2; ++ii) { const int s = (wid + 8 * ii) * 64 + lane, kk = (s >> 7) * 8 + ((s & 31) >> 2); vcol[ii] = ((s >> 5) & 3) * 32 + 8 * (s & 3); vkey[ii] = (kk & ~0xC) | ((kk & 4) << 1) | ((kk & 8) >> 1); }

    for (int L = vcu; L < 1024 + DB * NH; L += G) {
        int qrow0, keyrow0, NT, h, ntw; bool active;
        if (L < 1024) { const int bh = (L & 255) >> 3, s = L & 7, k = L >> 8; const int qb = (k == 0) ? s : (k == 1) ? 15 - s : (k == 2) ? 16 + s : 31 - s;
            const int b = bh >> 3; h = bh & 7; qrow0 = b * SEQ + qb * 256; keyrow0 = b * SEQ; NT = 4 * (qb + 1); ntw = 4 * qb + (wid >> 1) + 1; active = true; }
        else { const int v = L - 1024, b = v >> 3; h = v & 7; qrow0 = MP + b * DS; keyrow0 = MP + b * KEYS_S; NT = KEYS_S / 64; active = wid < 2; ntw = active ? NT : 0; }
        const char* ksrc[3]; int kstride[3]; const char* vsrc[2];
#pragma unroll
        for (int ii = 0; ii < 3; ++ii) {
            if (kcol[ii] < 128) { ksrc[ii] = (const char*)(KV + (size_t)(keyrow0 + krow[ii]) * KVW + h * 256 + kcol[ii]); kstride[ii] = 64 * KVW * 2; }
            else { ksrc[ii] = (const char*)(AKR + (size_t)(keyrow0 + krow[ii]) * ROPE + (kcol[ii] - 128)); kstride[ii] = 64 * ROPE * 2; }
        }
#pragma unroll
        for (int ii = 0; ii < 2; ++ii) vsrc[ii] = (const char*)(KV + (size_t)(keyrow0 + vkey[ii]) * KVW + h * 256 + 128 + vcol[ii]);
#define ATT_DMA(t, sl) do { \
        _Pragma("unroll") for (int ii = 0; ii < 3; ++ii) glds16(ksrc[ii] + (size_t)(t) * kstride[ii], (unsigned)__builtin_amdgcn_readfirstlane(ldsbase + (sl) * SLOT + (wid + 8 * ii) * 1024)); \
        _Pragma("unroll") for (int ii = 0; ii < 2; ++ii) glds16(vsrc[ii] + (size_t)(t) * (64 * KVW * 2), (unsigned)__builtin_amdgcn_readfirstlane(ldsbase + (sl) * SLOT + KBYTES + (wid + 8 * ii) * 1024)); } while (0)
        bf16x8 qr[12];
        if (active) { const bf16_t* Qw = Q + (size_t)(qrow0 + wid * 32 + r32) * QW + h * QHD + hi * 8;
#pragma unroll
            for (int d0 = 0; d0 < 12; ++d0) qr[d0] = *(const bf16x8*)(Qw + d0 * 16); }
        else {
#pragma unroll
            for (int d0 = 0; d0 < 12; ++d0) qr[d0] = (bf16x8){0, 0, 0, 0, 0, 0, 0, 0}; }
#pragma unroll
        for (int d0 = 0; d0 < 12; ++d0) asm volatile("" : "+v"(qr[d0]));
        ATT_DMA(0, 0);
        if (NT > 1) ATT_DMA(1, 1);
        float m_reg = -1e30f, l_reg = 0.f; f32x16 o[4];
#pragma unroll
        for (int d = 0; d < 4; ++d) o[d] = (f32x16){};
        int sl = 0;
        for (int t = 0; t < NT; ++t) {
            if (t + 1 < NT) asm volatile("s_waitcnt vmcnt(5)" ::: "memory"); else asm volatile("s_waitcnt vmcnt(0)" ::: "memory");
            __builtin_amdgcn_s_barrier(); asm volatile("" ::: "memory");
            if (t + 2 < NT) { const int sl2 = (sl >= 1) ? sl - 1 : 2; ATT_DMA(t + 2, sl2); }
            if (t < ntw) {
                const LAS char* Ks = (const LAS char*)(lds + sl * SLOT);
                f32x16 p0 = {}, p1 = {};
                int ka[4];
#pragma unroll
                for (int j = 0; j < 4; ++j) ka[j] = ldsbase + sl * SLOT + r32 * KROWB + ((j * 32 + hi * 16) ^ ((r32 & 7) << 4));
                bf16x8 kb[3][2];
#define ATT_KRD(d) do { asm volatile("ds_read_b128 %0, %1 offset:%2" : "=v"(kb[(d) % 3][0]) : "v"(ka[(d) & 3]), "i"(((d) >> 2) * 128) : "memory"); \
                        asm volatile("ds_read_b128 %0, %1 offset:%2" : "=v"(kb[(d) % 3][1]) : "v"(ka[(d) & 3]), "i"(((d) >> 2) * 128 + 32 * KROWB) : "memory"); } while (0)
                ATT_KRD(0); ATT_KRD(1);
#pragma unroll
                for (int d0 = 0; d0 < 12; ++d0) {
                    if (d0 + 2 < 12) { ATT_KRD(d0 + 2); asm volatile("s_waitcnt lgkmcnt(4)" ::: "memory"); }
                    else if (d0 + 1 < 12) asm volatile("s_waitcnt lgkmcnt(2)" ::: "memory");
                    else asm volatile("s_waitcnt lgkmcnt(0)" ::: "memory");
                    SBAR();
                    p0 = __builtin_amdgcn_mfma_f32_32x32x16_bf16(kb[d0 % 3][0], qr[d0], p0, 0, 0, 0);
                    p1 = __builtin_amdgcn_mfma_f32_32x32x16_bf16(kb[d0 % 3][1], qr[d0], p1, 0, 0, 0);
                    SBAR(); }
#undef ATT_KRD
                float mn, alpha; bf16x8 pa0, pa1, pa2, pa3;
                partialSM(p0, p1, m_reg, mn, alpha);
                finishSM(p0, p1, alpha, l_reg, pa0, pa1, pa2, pa3);
                if (__any(alpha < 1.f)) { if (hi == 0) al_l[r32] = alpha; asm volatile("s_waitcnt lgkmcnt(0)" ::: "memory");
#pragma unroll
                    for (int d = 0; d < 4; ++d)
#pragma unroll
                        for (int r = 0; r < 16; ++r) o[d][r] *= al_l[crow(r, hi)]; }
                const int vb = ldsbase + sl * SLOT + KBYTES + vbl;
                pv_one<0>(o[0], vb, pa0, pa1, pa2, pa3); pv_one<1>(o[1], vb, pa0, pa1, pa2, pa3); pv_one<2>(o[2], vb, pa0, pa1, pa2, pa3); pv_one<3>(o[3], vb, pa0, pa1, pa2, pa3);
            }
            sl = (sl == 2) ? 0 : sl + 1;
        }
        if (active) {

            if (hi == 0) li_l[r32] = l_reg; asm volatile("s_waitcnt lgkmcnt(0)" ::: "memory");
            int hi_o = hi, r32_o = r32; asm volatile("" : "+v"(hi_o), "+v"(r32_o));
            bf16_t* Ow = OUT + (size_t)(qrow0 + wid * 32) * DM + h * 128 + r32_o;
#pragma unroll
            for (int r = 0; r < 16; ++r) { const int orow = crow(r, hi_o); const float rl = __builtin_amdgcn_rcpf(li_l[orow]);
#pragma unroll
                for (int d0 = 0; d0 < 4; ++d0) Ow[(size_t)orow * DM + d0 * 32] = f2bf(o[d0][r] * rl); }
        }
        asm volatile("s_waitcnt lgkmcnt(0)" ::: "memory"); __builtin_amdgcn_s_barrier(); asm volatile("" ::: "memory");
#undef ATT_DMA
    }
}
#undef SBAR
}

namespace ret {
constexpr int QP = 528, VP = 144, PP = 144, XP = 68;
constexpr int OFF_Q = 0, OFF_K = 64 * QP, OFF_V = 2 * 64 * QP, OFF_P = OFF_V + 64 * VP, OFF_X = OFF_P + 64 * PP, END = OFF_X + 64 * XP * 4;
static_assert(END <= LDS_MAIN, "retention LDS");
typedef short v4i16 __attribute__((ext_vector_type(4)));
__device__ __forceinline__ s16x4 trd(const LAS unsigned char* p) { return __builtin_bit_cast(s16x4, __builtin_amdgcn_ds_read_tr16_b64_v4i16((LAS v4i16*)p)); }
#define RET_SB() __builtin_amdgcn_sched_barrier(0)
#define RET_BAR() do { asm volatile("s_waitcnt lgkmcnt(0)" ::: "memory"); __builtin_amdgcn_s_barrier(); asm volatile("" ::: "memory"); } while (0)

__device__ __forceinline__ void ret_phase(const Ctx& a, int i, LAS unsigned char* lds, int vcu, int G, bool store_o) {
    int tid_ = threadIdx.x; asm volatile("" : "+v"(tid_));
    const int tid = tid_, lane = tid & 63, l15 = lane & 15, kg = lane >> 4, tq = (lane & 15) >> 2, tp = lane & 3; const int wid = __builtin_amdgcn_readfirstlane(tid >> 6);
    const int dh = wid >> 2, dq = wid & 3;
    bf16_t* X = (bf16_t*)(a.ws + WS_ACT + A_INC);
    LAS unsigned char* QS = lds + OFF_Q; LAS unsigned char* KS = lds + OFF_K; LAS unsigned char* VS = lds + OFF_V; LAS unsigned char* PS = lds + OFF_P; LAS float* XS = (LAS float*)(lds + OFF_X);
    constexpr int NU_P = NB * RH * 8, NU_S = DB * RH * 8;
    for (int L = vcu; L < NU_P + NU_S; L += G) {
        int b, h, dvb, row0, nch; bool samp;
        if (L < NU_P) { samp = false; dvb = L & 7; h = (L >> 3) & 7; b = L >> 6; row0 = b * SEQ; nch = SEQ / 64; }
        else { const int v = L - NU_P; samp = true; dvb = v & 7; h = (v >> 3) & 7; b = v >> 6; row0 = MP + b * DS; nch = 1; }
        const float e1 = __builtin_amdgcn_exp2f(-5.0f - (float)h);
        const float log2g = -1.4426950408889634f * (e1 * (1.0f + e1 * (0.5f + e1 * (0.33333333f + e1 * (0.25f + e1 * (0.2f + e1 * (0.16666667f + e1 * 0.14285714f)))))));
        const float g64 = __builtin_amdgcn_exp2f(64.f * log2g);
        f32x4 S[8];
        if (samp) { const GAS float* sp = (const GAS float*)arg_in(6) + ((((size_t)i * DB + b) * RH + h) * RDK) * RDV + dvb * 64 + 16 * dq + l15 + (size_t)(64 * dh + 2 * kg) * RDV;
#pragma unroll
            for (int j = 0; j < 8; ++j) {
#pragma unroll
                for (int r = 0; r < 4; ++r) S[j][r] = sp[((r >> 1) + 128 * (r & 1)) * RDV];
                sp += 8 * RDV; asm volatile("" : "+v"(sp)); } }
        else {
#pragma unroll
            for (int j = 0; j < 8; ++j) S[j] = (f32x4){0.f, 0.f, 0.f, 0.f}; }
        const int srow = tid >> 5, scc = tid & 31, vrow = tid >> 3, vcc = tid & 7;
        const bf16_t* gq = X + (size_t)(row0 + srow) * INC + C_RQ + h * RDK + 8 * scc;
        const bf16_t* gv = X + (size_t)(row0 + vrow) * INC + C_RV + h * RDV + dvb * 64 + 8 * vcc;
        float kf[4], pf[4], of[2][4];
#pragma unroll
        for (int k = 0; k < 4; ++k) kf[k] = __builtin_amdgcn_exp2f((float)(63 - (srow + 16 * k)) * log2g);
#pragma unroll
        for (int r = 0; r < 4; ++r) pf[r] = __builtin_amdgcn_exp2f((float)(16 * (wid >> 1) + 4 * kg + r - 63) * log2g);
#pragma unroll
        for (int e = 0; e < 2; ++e)
#pragma unroll
            for (int r = 0; r < 4; ++r) of[e][r] = __builtin_amdgcn_exp2f((float)(16 * (2 * dh + e) + 4 * kg + r + 1) * log2g);
        u32x4 pq[4], pk[4], pv;
#pragma unroll
        for (int k = 0; k < 4; ++k) { pq[k] = *(const u32x4*)(gq + (size_t)(16 * k) * INC); pk[k] = *(const u32x4*)(gq + (size_t)(16 * k) * INC + C_RK); }
        pv = *(const u32x4*)gv;
#pragma unroll 1
        for (int c = 0; c < nch; ++c) {
#pragma unroll
            for (int k = 0; k < 4; ++k) {
                const int m = srow + 16 * k;
                *(LAS u32x4*)(QS + m * QP + scc * 16) = pq[k];
                const float f = kf[k];
                u32x4 w = pk[k];
                w.x = cvt_pk_bf16(bf_lo(w.x) * f, bf_hi(w.x) * f); w.y = cvt_pk_bf16(bf_lo(w.y) * f, bf_hi(w.y) * f); w.z = cvt_pk_bf16(bf_lo(w.z) * f, bf_hi(w.z) * f); w.w = cvt_pk_bf16(bf_lo(w.w) * f, bf_hi(w.w) * f);
                *(LAS u32x4*)(KS + m * QP + scc * 16) = w;
            }
            *(LAS u32x4*)(VS + vrow * VP + vcc * 16) = pv;
            RET_BAR();
            if (c + 1 < nch) {
                const size_t adv = (size_t)(c + 1) * 64 * INC;
#pragma unroll
                for (int k = 0; k < 4; ++k) { pq[k] = *(const u32x4*)(gq + adv + (size_t)(16 * k) * INC); pk[k] = *(const u32x4*)(gq + adv + (size_t)(16 * k) * INC + C_RK); }
                pv = *(const u32x4*)(gv + adv);
            }
            {
                const int nt = wid >> 1, mt0 = 2 * (wid & 1);
                f32x4 sc[2] = {(f32x4){0.f, 0.f, 0.f, 0.f}, (f32x4){0.f, 0.f, 0.f, 0.f}};
                bf16x8 fa[4][2], fb[4][2][2];
#define RET_LD1(gq) do { _Pragma("unroll") for (int k2 = 0; k2 < 2; ++k2) { const int ks = 2 * (gq) + k2; fa[gq][k2] = *(const LAS bf16x8*)(QS + (16 * nt + l15) * QP + (32 * ks + 8 * kg) * 2); \
                        _Pragma("unroll") for (int e = 0; e < 2; ++e) fb[gq][k2][e] = *(const LAS bf16x8*)(KS + (16 * (mt0 + e) + l15) * QP + (32 * ks + 8 * kg) * 2); } } while (0)
#define RET_MM1(gq) do { _Pragma("unroll") for (int k2 = 0; k2 < 2; ++k2) _Pragma("unroll") for (int e = 0; e < 2; ++e) sc[e] = __builtin_amdgcn_mfma_f32_16x16x32_bf16(fa[gq][k2], fb[gq][k2][e], sc[e], 0, 0, 0); } while (0)
                if (mt0 + 1 <= nt) {
                    RET_LD1(0); RET_LD1(1); RET_SB();
                    RET_MM1(0); RET_LD1(2); RET_SB();
                    RET_MM1(1); RET_LD1(3); RET_SB();
                    RET_MM1(2); RET_SB();
                    RET_MM1(3);
                } else if (mt0 <= nt) {
#define RET_LD1H(gq) do { _Pragma("unroll") for (int k2 = 0; k2 < 2; ++k2) { const int ks = 2 * (gq) + k2; fa[gq][k2] = *(const LAS bf16x8*)(QS + (16 * nt + l15) * QP + (32 * ks + 8 * kg) * 2); \
                        fb[gq][k2][0] = *(const LAS bf16x8*)(KS + (16 * mt0 + l15) * QP + (32 * ks + 8 * kg) * 2); } } while (0)
#define RET_MM1H(gq) do { _Pragma("unroll") for (int k2 = 0; k2 < 2; ++k2) sc[0] = __builtin_amdgcn_mfma_f32_16x16x32_bf16(fa[gq][k2], fb[gq][k2][0], sc[0], 0, 0, 0); } while (0)
                    RET_LD1H(0); RET_LD1H(1); RET_LD1H(2); RET_LD1H(3); RET_SB();
                    RET_MM1H(0); RET_MM1H(1); RET_MM1H(2); RET_MM1H(3);
#undef RET_LD1H
#undef RET_MM1H
                }
#undef RET_LD1
#undef RET_MM1
#pragma unroll
                for (int e = 0; e < 2; ++e)
#pragma unroll
                    for (int r = 0; r < 4; ++r) { const int n = 16 * nt + 4 * kg + r, m = 16 * (mt0 + e) + l15;
                        const float pvv = (m <= n) ? sc[e][r] * pf[r] : 0.f;
                        *(LAS bf16_t*)(PS + n * PP + m * 2) = f2bf(pvv); }
            }
            RET_BAR();
            bf16x8 vb[2];
#pragma unroll
            for (int ks = 0; ks < 2; ++ks) { const LAS unsigned char* p = VS + (32 * ks + 8 * kg + tq) * VP + (16 * dq + 4 * tp) * 2;
                const s16x4 lo = trd(p), hi4 = trd(p + 4 * VP); vb[ks] = (bf16x8){lo[0], lo[1], lo[2], lo[3], hi4[0], hi4[1], hi4[2], hi4[3]}; }
            f32x4 inn[2] = {(f32x4){0.f, 0.f, 0.f, 0.f}, (f32x4){0.f, 0.f, 0.f, 0.f}};
            f32x4 cx[4] = {(f32x4){0.f, 0.f, 0.f, 0.f}, (f32x4){0.f, 0.f, 0.f, 0.f}, (f32x4){0.f, 0.f, 0.f, 0.f}, (f32x4){0.f, 0.f, 0.f, 0.f}};
            {
                bf16x8 pa_[2][2]; u32x2 qa[4][4][2];
#define RET_LD2(s_) do { _Pragma("unroll") for (int nt = 0; nt < 4; ++nt) { const LAS unsigned char* p = QS + (16 * nt + l15) * QP + (128 * dh + 32 * (s_) + 4 * kg) * 2; \
                        qa[s_][nt][0] = *(const LAS u32x2*)p; qa[s_][nt][1] = *(const LAS u32x2*)(p + 32); } } while (0)
#define RET_MM2(s_) do { const u32x4 bw = {cvt_pk_bf16(S[2 * (s_)][0], S[2 * (s_)][1]), cvt_pk_bf16(S[2 * (s_)][2], S[2 * (s_)][3]), cvt_pk_bf16(S[2 * (s_) + 1][0], S[2 * (s_) + 1][1]), cvt_pk_bf16(S[2 * (s_) + 1][2], S[2 * (s_) + 1][3])}; \
                        const bf16x8 B = __builtin_bit_cast(bf16x8, bw); \
                        _Pragma("unroll") for (int nt = 0; nt < 4; ++nt) { const u32x4 aw = {qa[s_][nt][0].x, qa[s_][nt][0].y, qa[s_][nt][1].x, qa[s_][nt][1].y}; \
                            cx[nt] = __builtin_amdgcn_mfma_f32_16x16x32_bf16(__builtin_bit_cast(bf16x8, aw), B, cx[nt], 0, 0, 0); } } while (0)
#pragma unroll
                for (int e = 0; e < 2; ++e)
#pragma unroll
                    for (int ks = 0; ks < 2; ++ks) if (ks == 0 || dh == 1) pa_[e][ks] = *(const LAS bf16x8*)(PS + (16 * (2 * dh + e) + l15) * PP + (32 * ks + 8 * kg) * 2);
                RET_LD2(0); RET_LD2(1); RET_SB();
#pragma unroll
                for (int e = 0; e < 2; ++e)
#pragma unroll
                    for (int ks = 0; ks < 2; ++ks) if (ks == 0 || dh == 1) inn[e] = __builtin_amdgcn_mfma_f32_16x16x32_bf16(pa_[e][ks], vb[ks], inn[e], 0, 0, 0);
                RET_LD2(2); RET_SB();
                RET_MM2(0); RET_LD2(3); RET_SB();
                RET_MM2(1); RET_SB();
                RET_MM2(2); RET_SB();
                RET_MM2(3);
#undef RET_LD2
#undef RET_MM2
            }
            { const f32x4 g0 = dh ? cx[0] : cx[2], g1 = dh ? cx[1] : cx[3]; const int ntb = dh ? 0 : 2;
#pragma unroll
                for (int r = 0; r < 4; ++r) { XS[(16 * ntb + 4 * kg + r) * XP + 16 * dq + l15] = g0[r]; XS[(16 * (ntb + 1) + 4 * kg + r) * XP + 16 * dq + l15] = g1[r]; } }
            RET_BAR();
            { const f32x4 m0 = dh ? cx[2] : cx[0], m1 = dh ? cx[3] : cx[1];
                bf16_t* go = X + (size_t)(row0 + c * 64) * INC + C_RV + h * RDV + dvb * 64 + 16 * dq + l15;
#pragma unroll
                for (int e = 0; e < 2; ++e)
#pragma unroll
                    for (int r = 0; r < 4; ++r) { const int n = 16 * (2 * dh + e) + 4 * kg + r;
                        const float other = XS[n * XP + 16 * dq + l15]; const float mine = e ? m1[r] : m0[r];
                        const float ov = inn[e][r] + of[e][r] * (mine + other);
                        if (store_o) go[(size_t)n * INC] = f2bf(ov); } }
#pragma unroll
            for (int j = 0; j < 8; ++j) S[j] = S[j] * g64;
            {
                s16x4 kt[2][8][2];
#define RET_LD3(ks) do { _Pragma("unroll") for (int j = 0; j < 8; ++j) { const LAS unsigned char* p = KS + (32 * (ks) + 8 * kg + tq) * QP + (128 * dh + 16 * j + 4 * tp) * 2; kt[ks][j][0] = trd(p); kt[ks][j][1] = trd(p + 4 * QP); } } while (0)
#define RET_MM3(ks) do { _Pragma("unroll") for (int j = 0; j < 8; ++j) { const s16x4 lo = kt[ks][j][0], hi4 = kt[ks][j][1]; const bf16x8 A = (bf16x8){lo[0], lo[1], lo[2], lo[3], hi4[0], hi4[1], hi4[2], hi4[3]}; \
                        S[j] = __builtin_amdgcn_mfma_f32_16x16x32_bf16(A, vb[ks], S[j], 0, 0, 0); } } while (0)
                RET_LD3(0); RET_SB(); RET_LD3(1); RET_SB();
                RET_MM3(0); RET_SB();
                RET_MM3(1);
#undef RET_LD3
#undef RET_MM3
            }
            RET_BAR();
        }
        { GAS float* so = (GAS float*)(samp ? a.out + O_RET_S + ((((size_t)i * DB + b) * RH + h) * RDK) * RDV : a.out + O_RET_P + ((((size_t)i * NB + b) * RH + h) * RDK) * RDV) + dvb * 64 + 16 * dq + l15 + (size_t)(64 * dh + 2 * kg) * RDV;
#pragma unroll
            for (int j = 0; j < 8; ++j) {
#pragma unroll
                for (int r = 0; r < 4; ++r) so[((r >> 1) + 128 * (r & 1)) * RDV] = S[j][r];
                so += 8 * RDV; asm volatile("" : "+v"(so)); } }
    }
}
#undef RET_BAR
#undef RET_SB
}

#ifndef MK_PER_PHASE
#define MK_PER_PHASE 0
#endif
constexpr int PPL = 10, PH_FINAL = 1 + PPL * DEPTH, NPH = PH_FINAL + 1;

__global__ void __launch_bounds__(NTHREADS, 2) fwd_kernel(Args args) {
    extern __shared__ __attribute__((aligned(16))) unsigned char lds_raw[];
    LAS unsigned char* lds = (LAS unsigned char*)lds_raw;
        const int G = gridDim.x, bid = blockIdx.x;
    const int vcu = (G % 8 == 0) ? (bid % 8) * (G / 8) + bid / 8 : bid;
    const int NGW = G * NWAVES;
    const int lo = args.ph_lo, hi = args.ph_hi;
    if (threadIdx.x < 4) ((LAS unsigned*)(lds + LDSCTL_OFF))[threadIdx.x] = 0u;
    __syncthreads();
    XcdBarrier bar; bar.bar = (unsigned*)(args.ws + WS_CTL) + CW_BAR; bar.x = 0; bar.st = nullptr;
    if (!MK_PER_PHASE) bar = xcd_barrier_post((unsigned*)(args.ws + WS_CTL) + CW_BAR, (volatile LAS unsigned*)(lds + LDSCTL_OFF));
#define IN(k) (lo <= (k) && (k) < hi)
#define SEAM(k) do { if (!MK_PER_PHASE && (k) + 1 < hi) { XcdBarrier b2_ = bar; b2_.bar = opaque(bar.bar); { unsigned x_ = bar.x; asm volatile("" : "+s"(x_)); b2_.x = x_; } xcd_barrier(b2_); } } while (0)


    if (IN(0)) { Ctx al; al.ws = as_global(args.ws); al.out = as_global(args.out); ph_tables(al, G * NTHREADS); SEAM(0); }


#pragma unroll 1
    for (int L = 0; L < DEPTH; ++L) {
        const int base = 1 + PPL * L, i = L >> 1;
        Ctx al; al.ws = opaque(args.ws); al.out = opaque(args.out);
        unsigned char* const ws = al.ws;
        float* const X = al.out + O_Y;
        bf16_t* const H = (bf16_t*)(ws + WS_ACT + A_H);
        unsigned char* const wb = ws + WS_W + (size_t)(L & 1) * W_BUF;
        float* const rssA = (float*)(ws + WS_RSS); float* const rssB = (float*)(ws + WS_RSS + RSS_BANK); float* const rssP = (float*)(ws + WS_RSSP);
        const float* xp = (L == 0) ? arg_in(0) : X;
        const float* xs = (L == 0) ? arg_in(1) - (size_t)MP * DM : X;
        if (IN(base + 0)) {
            ph_convert(al, L, lds, 0, 1 << 30, 0, G);
            if (L == 0) { const f32x4* src = (const f32x4*)arg_in(1); f32x4* dst = (f32x4*)(X + (size_t)MP * DM);
                int t0 = threadIdx.x; asm volatile("" : "+v"(t0));
                for (int e = bid * NTHREADS + t0; e < MS * DM / 4; e += G * NTHREADS) dst[e] = src[e]; }
            if (L == 0) ph_xprep(xp, xs, H, rssA, 0, M, NGW, nullptr, 0, nullptr, nullptr);
            else { ph_xprep(X, X, H, rssA, MP, MP, NGW, nullptr, 0, nullptr, rssP); ph_xprep_samp(X, H, rssA, (const float*)(ws + WS_ACT + A_PART), FF / 512, (LAS float*)lds); }
            SEAM(base + 0);
        }
        if ((L & 1) == 0) {
            if (IN(base + 1)) {
                pg8::Gemm g{H, (const bf16_t*)(wb + W_INAB), M, INABP, DM, DM, DM, 0}; pg8::StaticOrder S; S.init(M, INABP, G, bid);
                pg8::EpiBf16<0> E{nullptr, 0, false, (bf16_t*)(ws + WS_ACT + A_INAB), INABP, rssA};
                pg8::gemm_phase<pg8::EpiBf16<0>, pg8::StaticOrder, true, true>(lds, g, S, E);
                SEAM(base + 1);
            }
            if (IN(base + 2)) {
                ph_mla_post(al, i, NGW);

                ph_s5<0>(al, i, lds, NGW);

                SEAM(base + 2);
            }
            if (IN(base + 3)) {
                ph_s5_carry(al, i, NGW);
                { pg8::Gemm g{(const bf16_t*)(ws + WS_ACT + A_CQN), (const bf16_t*)(wb + W_QB), M, QW, QL, QL, QL, 0}; pg8::StaticOrder S; S.init(M, QW, G, (bid + (G / 4)) % G);
                  pg8::EpiBf16<0> E{(const f32x2*)(ws + WS_ROPE), 2, false, (bf16_t*)(ws + WS_ACT + A_Q), QW, nullptr};
                  pg8::gemm_phase<pg8::EpiBf16<0>, pg8::StaticOrder, true, true>(lds, g, S, E); }
                { pg8::Gemm g{(const bf16_t*)(ws + WS_ACT + A_ACKV), (const bf16_t*)(wb + W_KVB), KROWS, KVW, KVL, KVL, KVL, 0}; pg8::StaticOrder S; S.init(KROWS, KVW, G, (bid + (G / 16) * 8) % G);
                  pg8::EpiBf16<0> E{nullptr, 0, false, (bf16_t*)(ws + WS_ACT + A_KV), KVW, nullptr};
                  pg8::gemm_phase<pg8::EpiBf16<0>, pg8::StaticOrder, true, true>(lds, g, S, E); }
                SEAM(base + 3);
            }
            if (IN(base + 4)) {

                ph_s5<1>(al, i, lds, NGW);

                SEAM(base + 4);
            }
            if (IN(base + 5)) {

                att::attn_phase(al, lds, vcu, G);

                { pg8::Gemm g{(const bf16_t*)(ws + WS_ACT + A_Z), (const bf16_t*)(wb + W_GLU), M, S5W, S5W, S5W, S5W, 0}; pg8::StaticOrder S; S.init(M, S5W, G, bid); if (G == 256) { S.skip = DB * NH; S.vc = vcu; }
                  pg8::EpiGlu E{(bf16_t*)(ws + WS_ACT + A_MIX), DM, S5W, (const bf16_t*)(ws + WS_ACT + A_Z), S5W, arg_in(24) + i * S5W};
                  pg8::gemm_phase<pg8::EpiGlu, pg8::StaticOrder, true, true>(lds, g, S, E); }
                SEAM(base + 5);
            }
            if (IN(base + 6)) {
                { pg8::Gemm g{(const bf16_t*)(ws + WS_ACT + A_MIX), (const bf16_t*)(wb + W_OUTAB), MP, DM, DM, DM, DM, 0}; pg8::StaticOrder S; S.init(MP, DM, G, bid, 4);
                  pg8::EpiRes E{xp, (L == 0) ? (const bf16_t*)nullptr : (const bf16_t*)H, DM, H, rssP};
                  pg8::gemm_phase<pg8::EpiRes, pg8::StaticOrder, true, true>(lds, g, S, E); }
                { pg8::Gemm g{(const bf16_t*)(ws + WS_ACT + A_MIX) + (size_t)MP * DM, (const bf16_t*)(wb + W_OUTAB), MS, DM, 256, DM, DM, 256}; pg8::SplitOrder S; S.init(MS, DM, DM / 256, G, bid);
                  pg8::EpiSlab E{(float*)(ws + WS_ACT + A_PART), DM, MS};
                  pg8::gemm_phase<pg8::EpiSlab, pg8::SplitOrder, true, true>(lds, g, S, E); }
                SEAM(base + 6);
            }
        } else {
            if (IN(base + 1)) {
                pg8::Gemm g{H, (const bf16_t*)(wb + W_INC), M, INC, DM, DM, DM, 0}; pg8::StaticOrder S; S.init(M, INC, G, bid);
                pg8::EpiBf16<0> E{(const f32x2*)(ws + WS_ROPE), 1, false, (bf16_t*)(ws + WS_ACT + A_INC), INC, rssA};
                pg8::gemm_phase<pg8::EpiBf16<0>, pg8::StaticOrder, true, true>(lds, g, S, E);
                SEAM(base + 2);
            }

            if (IN(base + 3)) {
                ret::ret_phase(al, i, lds, vcu, G, true); SEAM(base + 3); }

            if (IN(base + 4)) {
                ph_gn_gate(al, i, NGW); SEAM(base + 5); }
            if (IN(base + 6)) {
                { pg8::Gemm g{(const bf16_t*)(ws + WS_ACT + A_INC) + C_RV, (const bf16_t*)(wb + W_OUTC), MP, DM, RH * RDV, INC, RH * RDV, 0}; pg8::StaticOrder S; S.init(MP, DM, G, bid, 4);
                  pg8::EpiRes E{nullptr, H, DM, H, rssP};
                  pg8::gemm_phase<pg8::EpiRes, pg8::StaticOrder, true, true>(lds, g, S, E); }
                { pg8::Gemm g{(const bf16_t*)(ws + WS_ACT + A_INC) + C_RV + (size_t)MP * INC, (const bf16_t*)(wb + W_OUTC), MS, DM, 512, INC, RH * RDV, 512}; pg8::SplitOrder S; S.init(MS, DM, (RH * RDV) / 512, G, bid);
                  pg8::EpiSlab E{(float*)(wb + W_INC), DM, MS};
                  pg8::gemm_phase<pg8::EpiSlab, pg8::SplitOrder, true, true>(lds, g, S, E); }
                SEAM(base + 6);
            }
        }
        if (IN(base + 7)) {
            ph_xprep(X, X, H, rssB, MP, MP, NGW, nullptr, 0, nullptr, rssP); ph_xprep_samp(X, H, rssB, ((L & 1) == 0) ? (const float*)(ws + WS_ACT + A_PART) : (const float*)(wb + W_INC), 8, (LAS float*)lds);
            SEAM(base + 7); }
        if (IN(base + 8)) {
            pg8::Gemm g{H, (const bf16_t*)(wb + W_UP), M, FF, DM, DM, DM, 0}; pg8::StaticOrder S; S.init(M, FF, G, bid);
            pg8::EpiBf16<1> E{nullptr, 0, false, (bf16_t*)(ws + WS_ACT + A_FF), FF, rssB};
            pg8::gemm_phase<pg8::EpiBf16<1>, pg8::StaticOrder, true, true>(lds, g, S, E);
            SEAM(base + 8);
        }
        if (IN(base + 9)) {
            { pg8::Gemm g{(const bf16_t*)(ws + WS_ACT + A_FF), (const bf16_t*)(wb + W_DOWN), MP, DM, FF, FF, FF, 0}; pg8::StaticOrder S; S.init(MP, DM, G, bid, 4);
              pg8::EpiRes E{nullptr, H, DM, H, rssP};
              pg8::gemm_phase<pg8::EpiRes, pg8::StaticOrder, true, true>(lds, g, S, E); }
            { pg8::Gemm g{(const bf16_t*)(ws + WS_ACT + A_FF) + (size_t)MP * FF, (const bf16_t*)(wb + W_DOWN), MS, DM, 512, FF, FF, 512}; pg8::SplitOrder S; S.init(MS, DM, FF / 512, G, bid);
              pg8::EpiSlab E{(float*)(ws + WS_ACT + A_PART), DM, MS};
              pg8::gemm_phase<pg8::EpiSlab, pg8::SplitOrder, true, true>(lds, g, S, E); }
            SEAM(base + 9);
        }
    }
    if (IN(PH_FINAL)) { float* const X = as_global(args.out) + O_Y;
        ph_rmsnorm<true>(X, X, arg_in(9), nullptr, X, NGW, (const float*)(as_global(args.ws) + WS_ACT + A_PART), FF / 512, X, (const bf16_t*)(as_global(args.ws) + WS_ACT + A_H));

    }
#undef IN
#undef SEAM
}

extern "C" void kernel_launch(void* const* d_in, const int* in_sizes, int n_in, void* d_out, int out_size, void* d_ws, size_t ws_size, hipStream_t stream) {
    static int grid = 0;
    if (grid == 0) {
        if (n_in != 31 || out_size != (int)O_END || ws_size < WS_END) { fprintf(stderr, "kernel_launch: unexpected shapes: n_in %d out %d ws %zu (need %zu)\n", n_in, out_size, ws_size, (size_t)WS_END); grid = -1; return; }
        int dev = 0, cus = 0, per_cu = 0;
        if (hipGetDevice(&dev) != hipSuccess || hipDeviceGetAttribute(&cus, hipDeviceAttributeMultiprocessorCount, dev) != hipSuccess) { grid = -1; return; }
        if (hipFuncSetAttribute((const void*)fwd_kernel, hipFuncAttributeMaxDynamicSharedMemorySize, LDS_BYTES) != hipSuccess) { fprintf(stderr, "kernel_launch: hipFuncSetAttribute failed\n"); grid = -1; return; }
        if (hipOccupancyMaxActiveBlocksPerMultiprocessor(&per_cu, (const void*)fwd_kernel, NTHREADS, LDS_BYTES) != hipSuccess || per_cu < 1) { fprintf(stderr, "kernel_launch: occupancy query says %d blocks/CU\n", per_cu); (void)hipGetLastError(); grid = -1; return; }
        grid = cus;
    }
    if (grid < 0) return;
    if (hipMemsetAsync((char*)d_ws + WS_CTL, 0, CTL_ZERO_BYTES, stream) != hipSuccess) return;
    Args a{};
    for (int k = 0; k < 31; ++k) a.in[k] = (const float*)d_in[k];
    a.out = (float*)d_out; a.ws = (unsigned char*)d_ws;
#if MK_PER_PHASE
    for (int p = 0; p < NPH; ++p) {
        if (p >= 1 && p < PH_FINAL) { const int L = (p - 1) / PPL, k = (p - 1) % PPL; if ((L & 1) && (k == 5 || k == 2)) continue; }
        a.ph_lo = p; a.ph_hi = p + 1;
        hipLaunchKernelGGL(fwd_kernel, dim3(grid), dim3(NTHREADS), LDS_BYTES, stream, a);
    }
#else
    a.ph_lo = 0; a.ph_hi = NPH;
    hipLaunchKernelGGL(fwd_kernel, dim3(grid), dim3(NTHREADS), LDS_BYTES, stream, a);
#endif
    const hipError_t le = hipPeekAtLastError();
    if (le != hipSuccess) fprintf(stderr, "kernel_launch: launch failed: %s\n", hipGetErrorName(le));
}
```
